# Optimizing an MI355X kernel written in HIP

```python
import math
import jax, jax.numpy as jnp
from jax import lax
import numpy as np

D_MODEL = 1024
BATCH = 4
SEQ = 4096
DEPTH = 2

N_META = 16
BLOCK = 128
A_HEADS = 8
A_HEAD_DIM = 64
IDX_HEADS = 8
IDX_DIM = 64
TOPK_MAX = 256
N_BUCKETS = 32
MAX_DISTANCE = 128
B_HEADS = 4
B_QK_DIM = 128
B_V_DIM = 256
ROPE_BASE = 10000.0
C_HEADS = 16
C_HEAD_DIM = 64
D_FF = 2816
CONV_WIDTH = 3
EPS = 1e-6

A_Q = A_HEADS * A_HEAD_DIM
A_IQ = IDX_HEADS * IDX_DIM
B_QK = B_HEADS * B_QK_DIM
B_V = B_HEADS * B_V_DIM
EVEN_SPLITS = [A_Q, A_Q, A_Q, A_IQ, IDX_DIM, IDX_HEADS, B_QK, B_QK, B_V, B_V]
EVEN_IN = sum(EVEN_SPLITS)
EVEN_OUT = A_Q + B_V
C_W = C_HEADS * C_HEAD_DIM
ODD_IN = 3 * C_W

kernel_name = "hybrid_dsa_retention_stickbreaking_convffn"


def rmsnorm(x, g):
    xf = x.astype(jnp.float32)
    y = xf * lax.rsqrt(jnp.mean(jnp.square(xf), axis=-1, keepdims=True) + EPS)
    return (y * g.astype(jnp.float32)).astype(x.dtype)


def t5_bucket(rel):
    n = jnp.maximum(rel, 0)
    max_exact = N_BUCKETS // 2
    large = max_exact + (jnp.log(jnp.maximum(n, 1).astype(jnp.float32) / max_exact)
                         / math.log(MAX_DISTANCE / max_exact)
                         * (N_BUCKETS - max_exact)).astype(jnp.int32)
    large = jnp.minimum(large, N_BUCKETS - 1)
    return jnp.where(n < max_exact, n, large)


def rotary(x, pos):
    half = x.shape[-1] // 2
    inv = 1.0 / (ROPE_BASE ** (jnp.arange(half, dtype=jnp.float32) / half))
    ang = pos.astype(jnp.float32)[:, None] * inv[None, :]
    cos = jnp.cos(ang)[:, None, :]
    sin = jnp.sin(ang)[:, None, :]
    xf = x.astype(jnp.float32)
    x1, x2 = xf[..., :half], xf[..., half:]
    return jnp.concatenate([x1 * cos - x2 * sin, x2 * cos + x1 * sin], axis=-1).astype(x.dtype)


def dsa_attention(q, k, v, qi, ki, wi, rel_bias, n_keep):
    Bsz, L = q.shape[:2]
    nblk = L // BLOCK
    kpos = jnp.arange(L)
    is_meta = kpos < N_META

    def block(args):
        qb, qib, wib, qpos = args
        s = jnp.einsum('bqhd,bkd->bqhk', qib, ki).astype(jnp.float32) * (IDX_DIM ** -0.5)
        score = jnp.einsum('bqhk,bqh->bqk', jax.nn.relu(s), wib.astype(jnp.float32))
        causal = kpos[None, :] <= qpos[:, None]
        score = jnp.where(causal[None], jnp.where(is_meta[None, None, :], jnp.inf, score), -jnp.inf)
        _, idx = lax.top_k(score, n_keep)
        gather = jax.vmap(lambda a, i: a[i])
        ksel = gather(k, idx)
        vsel = gather(v, idx)
        rel = qpos[None, :, None] - idx
        bias = jnp.moveaxis(rel_bias[t5_bucket(rel)], -1, 2)
        logits = jnp.einsum('bqhd,bqkhd->bqhk', qb, ksel).astype(jnp.float32) * (A_HEAD_DIM ** -0.5)
        logits = logits + bias.astype(jnp.float32)
        logits = jnp.where((rel >= 0)[:, :, None, :], logits, -jnp.inf)
        p = jax.nn.softmax(logits, axis=-1).astype(v.dtype)
        return jnp.einsum('bqhk,bqkhd->bqhd', p, vsel)

    to_blocks = lambda a: jnp.moveaxis(a.reshape(Bsz, nblk, BLOCK, *a.shape[2:]), 1, 0)
    out = lax.map(block, (to_blocks(q), to_blocks(qi), to_blocks(wi), kpos.reshape(nblk, BLOCK)))
    return jnp.moveaxis(out, 0, 1).reshape(Bsz, L, *q.shape[2:])


def retention(q, k, v):
    Bsz, L, H, dk = q.shape
    dv = v.shape[-1]
    C = BLOCK
    N = L // C
    lg = jnp.log(1.0 - 2.0 ** (-5.0 - jnp.arange(H, dtype=jnp.float32)))
    n = jnp.arange(C, dtype=jnp.float32)
    diff = n[:, None] - n[None, :]
    dmat = jnp.where(diff[None] >= 0, jnp.exp(jnp.maximum(diff, 0.0)[None] * lg[:, None, None]), 0.0)
    xi = jnp.exp((n[None, :] + 1.0) * lg[:, None])[..., None]
    zeta = jnp.exp((C - 1.0 - n[None, :]) * lg[:, None])[..., None]
    g_chunk = jnp.exp(C * lg)[:, None, None]
    chunks = lambda a: a.astype(jnp.float32).reshape(Bsz, N, C, H, a.shape[-1]).transpose(1, 0, 3, 2, 4)
    qc, kc, vc = chunks(q), chunks(k * (dk ** -0.5)), chunks(v)

    def step(R, inp):
        qi, ki, vi = inp
        inner = jnp.einsum('bhcd,bhed->bhce', qi, ki) * dmat
        o = jnp.einsum('bhce,bhef->bhcf', inner, vi) + jnp.einsum('bhcd,bhdf->bhcf', qi, R) * xi
        R = R * g_chunk + jnp.einsum('bhcd,bhcf->bhdf', ki * zeta, vi)
        return R, o

    R0 = jnp.zeros((Bsz, H, dk, dv), jnp.float32)
    _, o = lax.scan(step, R0, (qc, kc, vc))
    return o.transpose(1, 0, 3, 2, 4).reshape(Bsz, L, H, dv)


def stick_breaking(q, k, v):
    L = q.shape[1]
    scale = q.shape[-1] ** -0.5
    outs = []
    for i in range(L // BLOCK):
        s, e = i * BLOCK, (i + 1) * BLOCK
        z = jnp.einsum('bqhd,bkhd->bhqk', q[:, s:e], k[:, :e]).astype(jnp.float32) * scale
        mask = (jnp.arange(e)[None, :] < jnp.arange(s, e)[:, None])[None, None]
        log_1m = jnp.where(mask, jax.nn.log_sigmoid(-z), 0.0)
        rest = lax.cumsum(log_1m, axis=3, reverse=True) - log_1m
        a = jnp.where(mask, jnp.exp(jax.nn.log_sigmoid(z) + rest), 0.0)
        outs.append(jnp.einsum('bhqk,bkhd->bqhd', a.astype(v.dtype), v[:, :e]))
    return jnp.concatenate(outs, axis=1)


def even_mixer(h, w_in, gn_gain, w_out, rel_bias, n_keep):
    Bsz, L, _ = h.shape
    p = h @ w_in
    splits = [int(s) for s in np.cumsum(EVEN_SPLITS)[:-1]]
    aq, ak, av, iq, ik, iw, bq, bk, bv, bg = jnp.split(p, splits, axis=-1)
    heads = lambda t, nh: t.reshape(Bsz, L, nh, -1)
    a_out = dsa_attention(heads(aq, A_HEADS), heads(ak, A_HEADS), heads(av, A_HEADS),
                          heads(iq, IDX_HEADS), ik, iw * (IDX_HEADS ** -0.5), rel_bias, n_keep)
    a_out = a_out.reshape(Bsz, L, A_Q)
    pos = jnp.arange(L)
    bq = rotary(heads(bq, B_HEADS), pos)
    bk = rotary(heads(bk, B_HEADS), pos)
    lead = (-N_META) % BLOCK
    frame = lambda t: jnp.pad(t[:, :L - lead], ((0, 0), (lead, 0), (0, 0), (0, 0)))
    r = retention(frame(bq), frame(bk), frame(heads(bv, B_HEADS)))
    r = jnp.pad(r[:, lead:], ((0, 0), (0, lead), (0, 0), (0, 0)))
    mu = jnp.mean(r, axis=-1, keepdims=True)
    var = jnp.mean(jnp.square(r - mu), axis=-1, keepdims=True)
    r = ((r - mu) * lax.rsqrt(var + EPS)).reshape(Bsz, L, B_V) * gn_gain.astype(jnp.float32)
    r_out = (r * jax.nn.silu(bg.astype(jnp.float32))).astype(h.dtype)
    return jnp.concatenate([a_out, r_out], axis=-1) @ w_out


def odd_mixer(h, w_in, w_out):
    Bsz, L, _ = h.shape
    q, k, v = jnp.split(h @ w_in, 3, axis=-1)
    heads = lambda t: t.reshape(Bsz, L, C_HEADS, C_HEAD_DIM)
    return stick_breaking(heads(q), heads(k), heads(v)).reshape(Bsz, L, C_W) @ w_out


def conv_ffn(h, w_up, w_gate, conv_w, conv_b, w_down):
    u = h @ w_up
    g = h @ w_gate
    g = lax.conv_general_dilated(g, conv_w[:, None, :].astype(g.dtype), window_strides=(1,),
                                 padding=[(CONV_WIDTH - 1, 0)],
                                 dimension_numbers=('NWC', 'WIO', 'NWC'),
                                 feature_group_count=D_FF) + conv_b
    return (jax.nn.silu(g) * u) @ w_down


def setup_inputs(seed: int = 0) -> dict:
    key = jax.random.key(seed)
    ks = jax.random.split(key, 20)
    f32 = jnp.float32
    ne, no = (DEPTH + 1) // 2, DEPTH // 2
    nrm = lambda k, shape, fan_in: jax.random.normal(k, shape, f32) * (fan_in ** -0.5)
    gain = lambda k, shape: 1.0 + 0.05 * jax.random.normal(k, shape, f32)
    return {
        "x": jax.random.normal(ks[0], (BATCH, SEQ, D_MODEL), f32),
        "meta_tokens": jax.random.normal(ks[1], (N_META, D_MODEL), f32),
        "rel_bias": 0.5 * jax.random.normal(ks[2], (N_BUCKETS, A_HEADS), f32),
        "norm_mix": gain(ks[3], (DEPTH, D_MODEL)),
        "norm_ffn": gain(ks[4], (DEPTH, D_MODEL)),
        "norm_final": gain(ks[5], (D_MODEL,)),
        "even_w_in": nrm(ks[6], (ne, D_MODEL, EVEN_IN), D_MODEL),
        "even_gn_gain": gain(ks[7], (ne, B_V)),
        "even_w_out": nrm(ks[8], (ne, EVEN_OUT, D_MODEL), EVEN_OUT),
        "odd_w_in": nrm(ks[9], (no, D_MODEL, ODD_IN), D_MODEL),
        "odd_w_out": nrm(ks[10], (no, C_W, D_MODEL), C_W),
        "ffn_w_up": nrm(ks[11], (DEPTH, D_MODEL, D_FF), D_MODEL),
        "ffn_w_gate": nrm(ks[12], (DEPTH, D_MODEL, D_FF), D_MODEL),
        "ffn_conv_w": nrm(ks[13], (DEPTH, CONV_WIDTH, D_FF), CONV_WIDTH),
        "ffn_conv_b": 0.01 * jax.random.normal(ks[14], (DEPTH, D_FF), f32),
        "ffn_w_down": nrm(ks[15], (DEPTH, D_FF, D_MODEL), D_FF),
    }


def reference(x, meta_tokens, rel_bias, norm_mix, norm_ffn, norm_final,
              even_w_in, even_gn_gain, even_w_out, odd_w_in, odd_w_out,
              ffn_w_up, ffn_w_gate, ffn_conv_w, ffn_conv_b, ffn_w_down):
    Bsz, S, D = x.shape
    lead = (-N_META) % BLOCK
    n_keep = min(TOPK_MAX, S // 4)
    meta = jnp.broadcast_to(meta_tokens[None].astype(x.dtype), (Bsz, N_META, D))
    h = jnp.concatenate([meta, x, jnp.zeros((Bsz, lead, D), x.dtype)], axis=1)
    for l in range(DEPTH):
        hn = rmsnorm(h, norm_mix[l])
        if l % 2 == 0:
            j = l // 2
            h = h + even_mixer(hn, even_w_in[j], even_gn_gain[j], even_w_out[j], rel_bias, n_keep)
        else:
            j = l // 2
            h = h + odd_mixer(hn, odd_w_in[j], odd_w_out[j])
        h = h + conv_ffn(rmsnorm(h, norm_ffn[l]), ffn_w_up[l], ffn_w_gate[l],
                         ffn_conv_w[l], ffn_conv_b[l], ffn_w_down[l])
    return rmsnorm(h, norm_final)[:, N_META:N_META + S]
```

```cpp
#include <hip/hip_runtime.h>
#include <hip/hip_bf16.h>
#include <cstdio>
#include <cstdint>
#include <cmath>

#define LAS __attribute__((address_space(3)))
#define GAS __attribute__((address_space(1)))
typedef unsigned short bf16_t;
typedef short bf16x8 __attribute__((ext_vector_type(8)));
typedef short s16x4 __attribute__((ext_vector_type(4)));
typedef float f32x4 __attribute__((ext_vector_type(4)));
typedef float f32x2 __attribute__((ext_vector_type(2)));
typedef float f32x16 __attribute__((ext_vector_type(16)));
typedef unsigned u32x4 __attribute__((ext_vector_type(4)));
typedef unsigned u32x2 __attribute__((ext_vector_type(2)));
typedef __bf16 bf16x2_t __attribute__((ext_vector_type(2)));
#define DI __device__ __forceinline__

constexpr int DM = 1024, NB = 4, SEQ = 4096, NMETA = 16, DFF = 2816;
constexpr int ROW0 = 256;
constexpr int MROW = 240;
constexpr int RT = ROW0 + NB * SEQ;
constexpr int NMT = RT / 256;
constexpr float EPS = 1e-6f;
constexpr float LOG2E = 1.4426950408889634f;
constexpr float LN2 = 0.6931471805599453f;
constexpr float C2 = 0.125f * LOG2E;
constexpr int N0 = 5376;
constexpr int NWAVES = 8;

DI unsigned cvt_pk_bf16(float lo, float hi) { f32x2 v = {lo, hi}; bf16x2_t b = __builtin_convertvector(v, bf16x2_t); return __builtin_bit_cast(unsigned, b); }
DI float bf2f(unsigned short u) { return __uint_as_float((unsigned)u << 16); }
DI float wave_sum(float v) {
#pragma unroll
    for (int o = 1; o < 64; o <<= 1) v += __shfl_xor(v, o);
    return v;
}
DI int opaque_tid() { int t = threadIdx.x; asm volatile("" : "+v"(t)); return t; }
#define LDS_WAIT() asm volatile("s_waitcnt lgkmcnt(0)" ::: "memory")
#define VM_WAIT() asm volatile("s_waitcnt vmcnt(0)" ::: "memory")

namespace pg8 {
constexpr int BM = 256, BK = 64, HALF = 128, HTB = HALF * BK * 2, STAGE_BYTES = 8 * HTB, NXCD = 8, WGM = 8;
__host__ __device__ __forceinline__ int lds_byte(int r, int c) { const int st = (r >> 4) * 2 + (c >> 5), rr = r & 15, cc = c & 31, ob = rr * 64 + cc * 2; return st * 1024 + (ob ^ (((ob >> 9) & 1) << 5)); }
__host__ __device__ __forceinline__ void stage_rc(int b, int& R, int& C) { const int st = b / 1024, sb = b % 1024, swz = sb ^ (((sb >> 9) & 1) << 5); R = (st >> 1) * 16 + swz / 64; C = (st & 1) * 32 + (swz % 64) / 2; }
__host__ __device__ __forceinline__ int perm32(int rho) { const int n = rho >> 4, i = rho & 15; return 8 * (i >> 2) + 4 * n + (i & 3); }

struct Unit { int pm, pn, arow, hrow; };
struct Gemm { const bf16_t* A; const bf16_t* Bt; int K; };

struct Order {
    int nM, nN, nwg, G, c;
    DI void init(int nM_, int nN_, int G_, int c_) { nM = nM_; nN = nN_; nwg = nM * nN; G = G_; c = c_; }
    DI bool tile(int i, int& pm, int& pn) const {
        const long L = (long)i * G + c; if (L >= nwg) return false;
        int wgid = (int)L; { const int q = nwg / NXCD, r = nwg % NXCD, xcd = wgid % NXCD, off = wgid / NXCD; wgid = (xcd < r ? xcd * (q + 1) : r * (q + 1) + (xcd - r) * q) + off; }
        const int nig = WGM * nN, gid = wgid / nig, fm = gid * WGM, gsz = (nM - fm) < WGM ? (nM - fm) : WGM;
        pm = fm + ((wgid % nig) % gsz); pn = (wgid % nig) / gsz; return true;
    }
};
struct SchedPlain {
    static constexpr bool HALO = false;
    Order o; int pm0;
    DI void init(int nM, int nN, int G, int c, int pm0_) { o.init(nM, nN, G, c); pm0 = pm0_; }
    DI bool next(int i, Unit& u) const { int pm, pn; if (!o.tile(i, pm, pn)) return false; u.pm = pm + pm0; u.pn = pn; u.arow = (pm + pm0) * 256; u.hrow = u.arow; return true; }
};
struct SchedFfn {
    static constexpr bool HALO = true;
    Order o;
    DI void init(int G, int c) { o.init(1 + 17 * NB, 22, G, c); }
    DI bool next(int i, Unit& u) const { int pm, pn; if (!o.tile(i, pm, pn)) return false; u.pm = pm; u.pn = pn;
        if (pm == 0) { u.arow = 0; u.hrow = 0; } else { const int b = (pm - 1) / 17, ii = (pm - 1) % 17; u.arow = ROW0 + SEQ * b + 254 * ii - 2; u.hrow = (ii == 0 && b > 0) ? (ROW0 - 2) : u.arow; }
        return true; }
};

template <class Epi, class Sched>
__device__ __forceinline__ void gemm_phase(LAS unsigned char* lds, const Gemm g, const Sched& S, const Epi& E) {
    const int tid = opaque_tid(), wid = __builtin_amdgcn_readfirstlane(tid >> 6), lane = tid & 63, wr = wid >> 2, wc = wid & 3, fr = lane & 15, fq = lane >> 4;
    const int K = g.K, nt = K / BK;
    unsigned voffA[2], voffB[2]; bool hsel[2];
#pragma unroll
    for (int i = 0; i < 2; ++i) { int R, C; stage_rc(tid * 16 + i * 8192, R, C); const int Rb = (R & ~31) + perm32(R & 31);
        voffA[i] = (unsigned)(R * K + C) * 2u; voffB[i] = (unsigned)(Rb * K + C) * 2u; hsel[i] = (R < 2); }
    const size_t kstep = (size_t)(BK * 2);
    const size_t hstep = (size_t)HALF * K * 2;
    const size_t tstep = 2 * hstep;
    const size_t rstep = (size_t)K * 2;
    const unsigned ldsw = (unsigned)wid * 1024u;
    const int aoff = lds_byte(wr * 64 + fr, fq * 8), boff = lds_byte(wc * 32 + fr, fq * 8);
#define PG8_SA(b, h) (((b) * 2 + (h)) * HTB)
#define PG8_SB(b, h) ((4 + (b) * 2 + (h)) * HTB)
#define PG8_STAGE(bufoff, gbase, voff) do { _Pragma("unroll") for (int _i = 0; _i < 2; ++_i) \
        __builtin_amdgcn_global_load_lds((const unsigned*)((const char*)(gbase) + (voff)[_i]), (LAS unsigned*)(lds + (bufoff) + ldsw + _i * 8192), 16, 0, 0); } while (0)
#define PG8_STAGE_A0(bufoff, gbase, dl) do { if constexpr (Sched::HALO) { _Pragma("unroll") for (int _i = 0; _i < 2; ++_i) \
        __builtin_amdgcn_global_load_lds((const unsigned*)((const char*)(gbase) + voffA[_i] + (hsel[_i] ? (dl) : (long)0)), (LAS unsigned*)(lds + (bufoff) + ldsw + _i * 8192), 16, 0, 0); } \
        else { PG8_STAGE(bufoff, gbase, voffA); } } while (0)
#define PG8_LDA(dst, b, h) do { _Pragma("unroll") for (int m = 0; m < 4; ++m) _Pragma("unroll") for (int k = 0; k < 2; ++k) dst[m][k] = *(const LAS bf16x8*)(lds + PG8_SA(b, h) + aoff + m * 2048 + k * 1024); } while (0)
#define PG8_LDB(dst, b, h) do { _Pragma("unroll") for (int n = 0; n < 2; ++n) _Pragma("unroll") for (int k = 0; k < 2; ++k) dst[n][k] = *(const LAS bf16x8*)(lds + PG8_SB(b, h) + boff + n * 2048 + k * 1024); } while (0)
#define PG8_MMA(ai, bj, At, Bt) do { __builtin_amdgcn_s_setprio(1); _Pragma("unroll") for (int m = 0; m < 4; ++m) _Pragma("unroll") for (int n = 0; n < 2; ++n) _Pragma("unroll") for (int k = 0; k < 2; ++k) \
        acc[ai][bj][m][n] = __builtin_amdgcn_mfma_f32_16x16x32_bf16(Bt[n][k], At[m][k], acc[ai][bj][m][n], 0, 0, 0); __builtin_amdgcn_s_setprio(0); } while (0)
#define PG8_WAIT_V(n) asm volatile("s_waitcnt vmcnt(" #n ")" ::: "memory")
#define PG8_WAIT_L(n) asm volatile("s_waitcnt lgkmcnt(" #n ")" ::: "memory")
#define PG8_BAR __builtin_amdgcn_s_barrier()
#define PG8_SCHED __builtin_amdgcn_sched_barrier(0)
    Unit cur, nxt; int ui = 0;
    if (!S.next(0, cur)) return;
    f32x4 acc[2][2][4][2];
#pragma unroll
    for (int a = 0; a < 2; ++a)
#pragma unroll
        for (int b = 0; b < 2; ++b)
#pragma unroll
            for (int m = 0; m < 4; ++m)
#pragma unroll
                for (int n = 0; n < 2; ++n) acc[a][b][m][n] = (f32x4){0.f, 0.f, 0.f, 0.f};
    bf16x8 At[4][2], B0[2][2], B1[2][2];
    const char* cA = (const char*)g.A + (size_t)cur.arow * rstep; const char* cB = (const char*)g.Bt + (size_t)cur.pn * tstep;
    long dc = (long)(cur.hrow - cur.arow) * (long)rstep;
    PG8_STAGE(PG8_SB(0, 0), cB, voffB); PG8_STAGE(PG8_SB(0, 1), cB + hstep, voffB); PG8_STAGE_A0(PG8_SA(0, 0), cA, dc); PG8_STAGE(PG8_SA(0, 1), cA + hstep, voffA);
    if (wr == 1) PG8_BAR;
    PG8_WAIT_V(2); PG8_BAR;
    PG8_STAGE(PG8_SB(1, 0), cB + kstep, voffB); PG8_STAGE_A0(PG8_SA(1, 0), cA + kstep, dc); PG8_STAGE(PG8_SB(1, 1), cB + hstep + kstep, voffB);
    PG8_WAIT_V(6); PG8_BAR;
    for (;;) {
        const bool has_next = S.next(ui + 1, nxt);
        const char* nA = has_next ? (const char*)g.A + (size_t)nxt.arow * rstep : cA; const char* nB = has_next ? (const char*)g.Bt + (size_t)nxt.pn * tstep : cB;
        const long dn = has_next ? (long)(nxt.hrow - nxt.arow) * (long)rstep : dc;
        for (int t = 0; t < nt; t += 2) {
            const bool last = (t == nt - 2);
            const char* a1 = cA + (size_t)(t + 1) * kstep;
            const char* a2 = last ? nA : cA + (size_t)(t + 2) * kstep; const char* b2 = last ? nB : cB + (size_t)(t + 2) * kstep;
            const char* a3 = a2 + kstep; const char* b3 = b2 + kstep;
            const long d2 = last ? dn : dc;
            PG8_LDB(B0, 0, 0); PG8_LDB(B1, 0, 1); PG8_SCHED; PG8_LDA(At, 0, 0); PG8_STAGE(PG8_SA(1, 1), a1 + hstep, voffA);
            PG8_WAIT_V(8); PG8_WAIT_L(0); PG8_BAR; PG8_MMA(0, 0, At, B0); PG8_MMA(0, 1, At, B1); PG8_BAR; PG8_SCHED;
            PG8_LDA(At, 0, 1); PG8_STAGE(PG8_SB(0, 0), b2, voffB); PG8_STAGE(PG8_SB(0, 1), b2 + hstep, voffB); PG8_STAGE_A0(PG8_SA(0, 0), a2, d2);
            PG8_WAIT_V(8); PG8_WAIT_L(0); PG8_BAR; PG8_MMA(1, 0, At, B0); PG8_MMA(1, 1, At, B1); PG8_BAR; PG8_SCHED;
            PG8_LDB(B0, 1, 0); PG8_LDB(B1, 1, 1); PG8_SCHED; PG8_LDA(At, 1, 0); PG8_STAGE(PG8_SA(0, 1), a2 + hstep, voffA);
            PG8_WAIT_V(8); PG8_WAIT_L(0); PG8_BAR; PG8_MMA(0, 0, At, B0); PG8_MMA(0, 1, At, B1); PG8_BAR; PG8_SCHED;
            PG8_LDA(At, 1, 1); PG8_STAGE(PG8_SB(1, 0), b3, voffB); PG8_STAGE(PG8_SB(1, 1), b3 + hstep, voffB); PG8_STAGE_A0(PG8_SA(1, 0), a3, d2);
            PG8_WAIT_V(8); PG8_WAIT_L(0); PG8_BAR; PG8_MMA(1, 0, At, B0); PG8_MMA(1, 1, At, B1); PG8_BAR; PG8_SCHED;
        }
        if (wr == 0) PG8_BAR;
        E(acc, cur, wr, wc, fr, fq, wid, lane);
        if (!has_next) break;
#pragma unroll
        for (int a = 0; a < 2; ++a)
#pragma unroll
            for (int b = 0; b < 2; ++b)
#pragma unroll
                for (int m = 0; m < 4; ++m)
#pragma unroll
                    for (int n = 0; n < 2; ++n) acc[a][b][m][n] = (f32x4){0.f, 0.f, 0.f, 0.f};
        cur = nxt; cA = nA; cB = nB; dc = dn; ++ui;
        if (wr == 1) PG8_BAR;
    }
    PG8_WAIT_V(0);
    PG8_BAR;
#undef PG8_SA
#undef PG8_SB
#undef PG8_STAGE
#undef PG8_STAGE_A0
#undef PG8_LDA
#undef PG8_LDB
#undef PG8_MMA
#undef PG8_WAIT_V
#undef PG8_WAIT_L
#undef PG8_BAR
#undef PG8_SCHED
}
}
constexpr size_t MiB = 1u << 20;
constexpr size_t WS_CTL = 0, CTL_ZERO_BYTES = 64 * 1024;
constexpr size_t WS_SSQ = 1 * MiB;
constexpr size_t WS_AK = 3 * MiB, WS_AV = 20 * MiB, WS_IQ = 37 * MiB;
constexpr size_t WS_H = 3 * MiB;
constexpr size_t WS_SC = 54 * MiB;
constexpr size_t WS_HB = 69 * MiB;
constexpr size_t WS_CAT = 122 * MiB;
constexpr size_t WS_BQ = 171 * MiB, WS_BKZ = 188 * MiB;
constexpr size_t WS_BV = 205 * MiB;
constexpr size_t WS_BIG = 104 * MiB;
constexpr size_t WS_Q1 = 104 * MiB, WS_K1 = 137 * MiB, WS_V1 = 170 * MiB;
constexpr size_t WS_END = 256 * MiB;
static_assert(WS_SSQ + (size_t)RT * 64 <= WS_AK && WS_IQ + (size_t)RT * 1024 <= WS_SC && WS_H + (size_t)RT * 4096 <= WS_HB, "ws map 1");
static_assert(WS_SC + 71303168 <= WS_CAT && WS_HB + (size_t)(RT + 1024) * 2048 <= WS_BIG && WS_CAT + (size_t)RT * 3072 <= WS_BQ, "ws map 2");
static_assert(WS_BQ + (size_t)RT * 1024 <= WS_BKZ && WS_BKZ + (size_t)RT * 1024 <= WS_BV && WS_BV + (size_t)RT * 2048 <= WS_END, "ws map 3");
static_assert(WS_BIG + (size_t)RT * DFF * 2 <= WS_END && WS_Q1 + (size_t)RT * 2048 <= WS_K1 && WS_K1 + (size_t)RT * 2048 <= WS_V1 && WS_V1 + (size_t)RT * 2048 <= WS_END, "ws map 4");
constexpr size_t DO_WIN0 = 0;
constexpr size_t DO_RS = 0;
constexpr size_t DO_WOUT0 = 0, DO_WUG0 = 3 * MiB, DO_WDN0 = 14 * MiB, DO_WIN1 = 20 * MiB, DO_WOUT1 = 26 * MiB;
constexpr size_t DO_BM = 32 * MiB;
constexpr size_t DO_ROT = 40 * MiB;
constexpr size_t DO_IK = 43 * MiB;
constexpr size_t DO_IW = 46 * MiB;
constexpr size_t DO_WUG1 = 47 * MiB, DO_WDN1 = 58 * MiB;
static_assert(DO_WDN1 + (size_t)1024 * DFF * 2 <= 64 * MiB && DO_WOUT1 + 2 * MiB <= DO_BM && DO_ROT + 4112 * 64 * 8 <= DO_IK && DO_IK + (size_t)RT * 128 <= DO_IW && DO_IW + (size_t)RT * 32 <= DO_WUG1, "d_out map");
constexpr int CW_TMO = 0, CW_BAR = 1024;
constexpr size_t SC_BATCH = 8912896;

constexpr int RING_BYTES = 131072;
constexpr int LDSX_OFF = RING_BYTES;
constexpr int LDSCTL_OFF = RING_BYTES + 8192, MISC_OFF = LDSCTL_OFF + 320;
constexpr int LDS_BYTES = 147456;

typedef GAS unsigned gu32;
#define RLX_AGENT __ATOMIC_RELAXED, __HIP_MEMORY_SCOPE_AGENT

#define XB_TMO      128
#define XB_XCNT(j)  (256  + 64 * (j))
#define XB_XSUB(j)  (1280 + 64 * (j))
#define XB_XGEN(j)  (2304 + 64 * (j))
#define XB_TOP      3328
#define XB_TOPGEN   3392
#define XCD_BAR_WORDS 3456
#define XB_SPIN_CAP (1u << 18)
DI unsigned xb_ld(unsigned* p)              { return __hip_atomic_load(p, __ATOMIC_RELAXED, __HIP_MEMORY_SCOPE_AGENT); }
DI unsigned xb_add(unsigned* p, unsigned v) { return __hip_atomic_fetch_add(p, v, __ATOMIC_RELAXED, __HIP_MEMORY_SCOPE_AGENT); }
DI unsigned xb_xcc_id() { return (unsigned)__builtin_amdgcn_s_getreg((3 << 11) | 20) & 0xFu; }
#define XB_SPIN(cond, bar) do { unsigned _sp = 0; while (cond) { __builtin_amdgcn_s_sleep(1); \
    if ((++_sp & 255u) == 0u) { if (xb_ld(&(bar)[XB_TMO])) break; if (_sp > XB_SPIN_CAP) { atomicAdd(&(bar)[XB_TMO], 1u); break; } } } } while (0)
struct XcdBarrier { unsigned* bar; unsigned x; volatile LAS unsigned* st; };
DI XcdBarrier xcd_barrier_post(unsigned* bar, volatile LAS unsigned* st) {
    XcdBarrier b; b.bar = bar; b.x = xb_xcc_id(); b.st = st;
    if (threadIdx.x == 0) (void)xb_add(&bar[XB_XCNT(b.x)], 1u);
    return b;
}
DI void xcd_barrier_complete(unsigned* bar, unsigned x, unsigned& nloc, unsigned& nx) {
    const unsigned G = gridDim.x * gridDim.y * gridDim.z;
    unsigned sum, cnt, mine, sp = 0u;
    for (;;) {
        sum = 0u; cnt = 0u; mine = 0u;
#pragma unroll
        for (unsigned j = 0; j < 16; ++j) { const unsigned c = xb_ld(&bar[XB_XCNT(j)]); sum += c; cnt += (c > 0u) ? 1u : 0u; mine = (j == x) ? c : mine; }
        if (sum == G) break;
        __builtin_amdgcn_s_sleep(1);
        if ((++sp & 255u) == 0u) { if (xb_ld(&bar[XB_TMO])) break; if (sp > XB_SPIN_CAP) { atomicAdd(&bar[XB_TMO], 1u); break; } }
    }
    nloc = mine > 0u ? mine : 1u; nx = cnt > 0u ? cnt : 1u;
}
DI void xcd_barrier(const XcdBarrier& b) {
    asm volatile("s_waitcnt vmcnt(0)" ::: "memory");
    __syncthreads();
    if (threadIdx.x == 0) {
        unsigned* bar = b.bar;
        __builtin_amdgcn_s_waitcnt(0);
        unsigned nloc = b.st[0], nx = b.st[1];
        if (nloc == 0u) { xcd_barrier_complete(bar, b.x, nloc, nx); b.st[0] = nloc; b.st[1] = nx; }
        const unsigned old = xb_add(&bar[XB_XSUB(b.x)], 1u);
        const unsigned gen = old / nloc;
        if (old + 1u == (gen + 1u) * nloc) {
            __builtin_amdgcn_fence(__ATOMIC_RELEASE, "agent");
            asm volatile("s_waitcnt vmcnt(0)" ::: "memory");
            const unsigned og = xb_add(&bar[XB_TOP], 1u);
            const unsigned tg = og / nx;
            if (og + 1u == (tg + 1u) * nx) xb_add(&bar[XB_TOPGEN], 1u);
            else XB_SPIN(xb_ld(&bar[XB_TOPGEN]) == tg, bar);
            __builtin_amdgcn_fence(__ATOMIC_ACQUIRE, "agent");
            xb_add(&bar[XB_XGEN(b.x)], 1u);
            asm volatile("s_waitcnt vmcnt(0)" ::: "memory");
        } else {
            XB_SPIN(xb_ld(&bar[XB_XGEN(b.x)]) == gen, bar);
            __builtin_amdgcn_fence(__ATOMIC_ACQUIRE, "agent");
            asm volatile("s_waitcnt vmcnt(0)" ::: "memory");
        }
    }
    __syncthreads();
}

struct Params {
    const float* x; const float* meta; const float* relb; const float* nmix; const float* nffn; const float* nfin;
    const float* win0; const float* gng; const float* wout0; const float* win1; const float* wout1;
    const float* wup; const float* wgate; const float* convw; const float* convb; const float* wdown;
    float* out; unsigned char* ws; int ph_lo, ph_hi;
};

DI int g0_src(int n) {
    const int pn = n >> 8, c = n & 255;
    if (pn < 8) return n;
    if (pn == 8) return c < 64 ? 2048 + c : (c < 72 ? 2112 + (c - 64) : -1);
    if (pn < 13) { const int base = pn < 11 ? 2120 : 2632, t = pn < 11 ? pn - 9 : pn - 11, half = c >> 7, cc = c & 127; return base + 128 * (2 * t + (cc >> 6)) + 64 * half + (cc & 63); }
    if (pn < 17) return 3144 + 256 * (pn - 13) + c;
    return 4168 + 256 * (pn - 17) + c;
}
template <int MODE>
DI void transpose_item(const float* W, const float* W2, int K, int N, bf16_t* WT, const float* gain, LAS float* scr, int item, int lane) {
    const int nblk = N / 32, kb = item / nblk, nb = item % nblk, k0 = 64 * kb, n0 = 32 * nb;
    const int n = n0 + (lane & 31);
    const float* src = W; int sc = n, ld = N;
    if (MODE == 1) { sc = g0_src(n); ld = 5192; }
    if (MODE == 2) { const int j = n >> 8, c = n & 255; if (c < 128) { sc = 128 * j + c; } else { src = W2; sc = 128 * j + c - 128; } ld = DFF; }
#pragma unroll 8
    for (int i = 0; i < 32; ++i) { const int kk = 2 * i + (lane >> 5); float v = 0.f; if (sc >= 0) v = src[(size_t)(k0 + kk) * ld + sc]; if (gain) v *= gain[k0 + kk]; scr[kk * 33 + (lane & 31)] = v; }
    LDS_WAIT(); asm volatile("" ::: "memory");
    const int c = lane & 7;
#pragma unroll
    for (int j = 0; j < 4; ++j) { const int nn = (lane >> 3) + 8 * j; const LAS float* s = scr + (8 * c) * 33 + nn;
        u32x4 o; o.x = cvt_pk_bf16(s[0 * 33], s[1 * 33]); o.y = cvt_pk_bf16(s[2 * 33], s[3 * 33]); o.z = cvt_pk_bf16(s[4 * 33], s[5 * 33]); o.w = cvt_pk_bf16(s[6 * 33], s[7 * 33]);
        *(u32x4*)(WT + (size_t)(n0 + nn) * K + k0 + 8 * c) = o; }
    LDS_WAIT(); asm volatile("" ::: "memory");
}
DI const float* h0_row(const Params& P, int r) { return r < MROW ? nullptr : (r < ROW0 ? P.meta + (size_t)(r - MROW) * DM : P.x + (size_t)(r - ROW0) * DM); }
DI float row_rnorm(const float* ssq, int r) {
    const f32x4* p = (const f32x4*)(ssq + (size_t)r * 16); const f32x4 a = p[0], b = p[1], c = p[2], d = p[3];
    const float s = ((a.x + a.y) + (a.z + a.w)) + ((b.x + b.y) + (b.z + b.w)) + ((c.x + c.y) + (c.z + c.w)) + ((d.x + d.y) + (d.z + d.w));
    return 1.0f / sqrtf(s * (1.0f / DM) + EPS);
}
#define EPI_ARGS const f32x4 (&acc)[2][2][4][2], const pg8::Unit& u, int wr, int wc, int fr, int fq, int wid, int lane
DI float gamma_log2(int h) { return log2f(1.0f - exp2f(-5.0f - (float)h)); }
DI void unit_rnorm(LAS float* RN, const float* ssq, int arow) {
    const int t = threadIdx.x;
    if (t < 256) { int row = arow + t; row = row < RT ? row : RT - 1; RN[t] = row_rnorm(ssq, row); }
    asm volatile("s_waitcnt lgkmcnt(0)" ::: "memory"); __builtin_amdgcn_s_barrier(); asm volatile("" ::: "memory");
}

struct EpiG0 {
    bf16_t *CAT, *AK, *AV, *IQ, *IK, *BQ, *BKZ, *BV; float* IW; const float* ssq; const f32x2* rot; LAS float* RN;
    DI void operator()(EPI_ARGS) const {
        const int pn = u.pn;
        unit_rnorm(RN, ssq, u.arow);
        float rs[2][4];
#pragma unroll
        for (int ai = 0; ai < 2; ++ai)
#pragma unroll
            for (int m = 0; m < 4; ++m) rs[ai][m] = RN[128 * ai + 64 * wr + 16 * m + fr];
        if (pn < 8 || pn >= 13) {
            bf16_t* base; int pitch, col0; float sc = 1.f;
            if (pn < 2) { base = CAT; pitch = 1536; col0 = 256 * pn; sc = C2; }
            else if (pn < 4) { base = AK; pitch = 512; col0 = 256 * (pn - 2); }
            else if (pn < 6) { base = AV; pitch = 512; col0 = 256 * (pn - 4); }
            else if (pn < 8) { base = IQ; pitch = 512; col0 = 256 * (pn - 6); sc = 0.125f; }
            else if (pn < 17) { base = BV; pitch = 1024; col0 = 256 * (pn - 13); }
            else { base = CAT; pitch = 1536; col0 = 512 + 256 * (pn - 17); }
            col0 += 32 * wc + 8 * fq;
#pragma unroll
            for (int ai = 0; ai < 2; ++ai)
#pragma unroll
                for (int m = 0; m < 4; ++m) { const int row = u.arow + 128 * ai + 64 * wr + 16 * m + fr; const float s = rs[ai][m] * sc; bf16_t* rp = base + (size_t)row * pitch + col0;
#pragma unroll
                    for (int bj = 0; bj < 2; ++bj) { const f32x4 v0 = acc[ai][bj][m][0] * s, v1 = acc[ai][bj][m][1] * s;
                        u32x4 w; w.x = cvt_pk_bf16(v0[0], v0[1]); w.y = cvt_pk_bf16(v0[2], v0[3]); w.z = cvt_pk_bf16(v1[0], v1[1]); w.w = cvt_pk_bf16(v1[2], v1[3]);
                        *(u32x4*)(rp + bj * 128) = w; } }
        } else if (pn == 8) {
#pragma unroll
            for (int ai = 0; ai < 2; ++ai)
#pragma unroll
                for (int m = 0; m < 4; ++m) { const int row = u.arow + 128 * ai + 64 * wr + 16 * m + fr; const float s = rs[ai][m];
                    if (wc < 2) { const f32x4 v0 = acc[ai][0][m][0] * s, v1 = acc[ai][0][m][1] * s;
                        u32x4 w; w.x = cvt_pk_bf16(v0[0], v0[1]); w.y = cvt_pk_bf16(v0[2], v0[3]); w.z = cvt_pk_bf16(v1[0], v1[1]); w.w = cvt_pk_bf16(v1[2], v1[3]);
                        *(u32x4*)(IK + (size_t)row * 64 + 32 * wc + 8 * fq) = w; }
                    else if (wc == 2 && fq == 0) { const float s2 = s * 0.35355339059327373f; *(f32x4*)(IW + (size_t)row * 8) = acc[ai][0][m][0] * s2; *(f32x4*)(IW + (size_t)row * 8 + 4) = acc[ai][0][m][1] * s2; } }
        } else {
            const bool isk = pn >= 11; const int t = isk ? pn - 11 : pn - 9, head = 2 * t + (wc >> 1), i0 = 32 * (wc & 1) + 8 * fq;
            bf16_t* base = isk ? BKZ : BQ; const float lg = gamma_log2(head);
#pragma unroll
            for (int ai = 0; ai < 2; ++ai)
#pragma unroll
                for (int m = 0; m < 4; ++m) { const int row = u.arow + 128 * ai + 64 * wr + 16 * m + fr;
                    int pos = row < ROW0 ? row - MROW : 16 + ((row - ROW0) & (SEQ - 1)); pos = pos < 0 ? 0 : pos;
                    float s = rs[ai][m]; if (isk) s *= 0.08838834764831845f * exp2f((float)(127 - (row & 127)) * lg);
                    const f32x4* rp = (const f32x4*)(rot + (size_t)pos * 64 + i0); const f32x4 r0 = rp[0], r1 = rp[1], r2 = rp[2], r3 = rp[3];
                    const float cs[8] = {r0[0], r0[2], r1[0], r1[2], r2[0], r2[2], r3[0], r3[2]}, sn[8] = {r0[1], r0[3], r1[1], r1[3], r2[1], r2[3], r3[1], r3[3]};
                    float o1[8], o2[8];
#pragma unroll
                    for (int n = 0; n < 2; ++n)
#pragma unroll
                        for (int j = 0; j < 4; ++j) { const float x1 = acc[ai][0][m][n][j] * s, x2 = acc[ai][1][m][n][j] * s; o1[4 * n + j] = x1 * cs[4 * n + j] - x2 * sn[4 * n + j]; o2[4 * n + j] = x2 * cs[4 * n + j] + x1 * sn[4 * n + j]; }
                    u32x4 w1, w2; w1.x = cvt_pk_bf16(o1[0], o1[1]); w1.y = cvt_pk_bf16(o1[2], o1[3]); w1.z = cvt_pk_bf16(o1[4], o1[5]); w1.w = cvt_pk_bf16(o1[6], o1[7]);
                    w2.x = cvt_pk_bf16(o2[0], o2[1]); w2.y = cvt_pk_bf16(o2[2], o2[3]); w2.z = cvt_pk_bf16(o2[4], o2[5]); w2.w = cvt_pk_bf16(o2[6], o2[7]);
                    bf16_t* op = base + (size_t)row * 512 + 128 * head + i0; *(u32x4*)op = w1; *(u32x4*)(op + 64) = w2; }
        }
    }
};

template <bool FIRST>
struct EpiResid {
    Params P; float* H; bf16_t* HB; float* ssq;
    DI void operator()(EPI_ARGS) const {
        const int colb = 256 * u.pn + 32 * wc + 8 * fq;
#pragma unroll
        for (int ai = 0; ai < 2; ++ai)
#pragma unroll
            for (int m = 0; m < 4; ++m) { const int row = u.arow + 128 * ai + 64 * wr + 16 * m + fr; float sq = 0.f;
                const float* bp = FIRST ? h0_row(P, row) : H + (size_t)row * DM;
#pragma unroll
                for (int bj = 0; bj < 2; ++bj) { const int col = colb + 128 * bj;
                    f32x4 b0 = {0.f, 0.f, 0.f, 0.f}, b1 = {0.f, 0.f, 0.f, 0.f};
                    if (bp) { b0 = *(const f32x4*)(bp + col); b1 = *(const f32x4*)(bp + col + 4); }
                    const f32x4 v0 = b0 + acc[ai][bj][m][0], v1 = b1 + acc[ai][bj][m][1];
                    *(f32x4*)(H + (size_t)row * DM + col) = v0; *(f32x4*)(H + (size_t)row * DM + col + 4) = v1;
                    u32x4 w; w.x = cvt_pk_bf16(v0[0], v0[1]); w.y = cvt_pk_bf16(v0[2], v0[3]); w.z = cvt_pk_bf16(v1[0], v1[1]); w.w = cvt_pk_bf16(v1[2], v1[3]);
                    *(u32x4*)(HB + (size_t)row * DM + col) = w;
                    sq += (v0[0] * v0[0] + v0[1] * v0[1]) + (v0[2] * v0[2] + v0[3] * v0[3]) + (v1[0] * v1[0] + v1[1] * v1[1]) + (v1[2] * v1[2] + v1[3] * v1[3]); }
                sq += __shfl_xor(sq, 16); sq += __shfl_xor(sq, 32);
                if (fq == 0) ssq[(size_t)row * 16 + 4 * u.pn + wc] = sq; }
    }
};

struct EpiQKV1 {
    bf16_t *Q1, *K1, *V1; const float* ssq; LAS float* RN;
    DI void operator()(EPI_ARGS) const {
        unit_rnorm(RN, ssq, u.arow);
        const int pn = u.pn; bf16_t* base = Q1 + (size_t)(pn >> 2) * ((WS_K1 - WS_Q1) / 2);     const float sc = pn < 4 ? 0.125f : 1.f; const int col0 = 256 * (pn & 3) + 32 * wc + 8 * fq;
#pragma unroll
        for (int ai = 0; ai < 2; ++ai)
#pragma unroll
            for (int m = 0; m < 4; ++m) { const int row = u.arow + 128 * ai + 64 * wr + 16 * m + fr; const float s = RN[128 * ai + 64 * wr + 16 * m + fr] * sc; bf16_t* rp = base + (size_t)row * DM + col0;
#pragma unroll
                for (int bj = 0; bj < 2; ++bj) { const f32x4 v0 = acc[ai][bj][m][0] * s, v1 = acc[ai][bj][m][1] * s;
                    u32x4 w; w.x = cvt_pk_bf16(v0[0], v0[1]); w.y = cvt_pk_bf16(v0[2], v0[3]); w.z = cvt_pk_bf16(v1[0], v1[1]); w.w = cvt_pk_bf16(v1[2], v1[3]);
                    *(u32x4*)(rp + bj * 128) = w; } }
    }
};

DI float ror16(float v, int k, int lane) { return __shfl(v, (lane & 48) | ((lane - k) & 15)); }
struct EpiFfn {
    bf16_t* ACT; const float* ssq; const float* cw; const float* cb; LAS float* X; LAS float* RN;
    DI void operator()(EPI_ARGS) const {
        const int cl = 32 * wc + 8 * fq, cg = 128 * u.pn + cl;
        if (fr >= 14) {
#pragma unroll
            for (int ai = 0; ai < 2; ++ai) { LAS float* xp = X + ((ai * 2 + wr) * 2 + (fr - 14)) * 128 + cl;
                *(LAS f32x4*)xp = acc[ai][1][3][0]; *(LAS f32x4*)(xp + 4) = acc[ai][1][3][1]; }
        }
        unit_rnorm(RN, ssq, u.arow);
        float rs[2][4];
#pragma unroll
        for (int ai = 0; ai < 2; ++ai)
#pragma unroll
            for (int m = 0; m < 4; ++m) rs[ai][m] = RN[128 * ai + 64 * wr + 16 * m + fr];
        const int bidx = u.pm == 0 ? 0 : (u.pm - 1) / 17; const int rend = u.pm == 0 ? 256 : ROW0 + SEQ * (bidx + 1);
#pragma unroll
        for (int q = 0; q < 2; ++q) {
            const f32x4 w0 = *(const f32x4*)(cw + cg + 4 * q), w1 = *(const f32x4*)(cw + DFF + cg + 4 * q), w2 = *(const f32x4*)(cw + 2 * DFF + cg + 4 * q), bb = *(const f32x4*)(cb + cg + 4 * q);
#pragma unroll
            for (int ai = 0; ai < 2; ++ai) {
                f32x4 pv = {0.f, 0.f, 0.f, 0.f};
                const int g = ai * 2 + wr;
                if (g > 0 && fr >= 14) pv = *(const LAS f32x4*)(X + ((g - 1) * 2 + (fr - 14)) * 128 + cl + 4 * q) * RN[64 * (g - 1) + 48 + fr];
#pragma unroll
                for (int m = 0; m < 4; ++m) { const int rt = 128 * ai + 64 * wr + 16 * m + fr, row = u.arow + rt; const float s = rs[ai][m]; float o[4];
#pragma unroll
                    for (int j = 0; j < 4; ++j) { const float cur = acc[ai][1][m][q][j] * s; const float c1 = ror16(cur, 1, lane), c2 = ror16(cur, 2, lane), q1 = ror16(pv[j], 1, lane), q2 = ror16(pv[j], 2, lane);
                        const float p1 = fr >= 1 ? c1 : q1, p2 = fr >= 2 ? c2 : q2;
                        const float gc = w0[j] * p2 + w1[j] * p1 + w2[j] * cur + bb[j];
                        const float sg = __builtin_amdgcn_rcpf(1.0f + __builtin_amdgcn_exp2f(-gc * LOG2E));
                        o[j] = gc * sg * (acc[ai][0][m][q][j] * s); pv[j] = cur; }
                    const bool ok = (u.pm == 0 || rt >= 2) && row < rend;
                    if (ok) { u32x2 w; w.x = cvt_pk_bf16(o[0], o[1]); w.y = cvt_pk_bf16(o[2], o[3]); *(u32x2*)(ACT + (size_t)row * DFF + cg + 4 * q) = w; } }
            }
        }
    }
};
namespace att {
constexpr int A_K = 0, A_V = 16384, A_WS = 32768, A_OST = 34816, A_TB = 67584, A_FLG = 68096;
DI int crow(int r, int hi) { return (r & 3) + 8 * (r >> 2) + 4 * hi; }
#define SBAR() __builtin_amdgcn_sched_barrier(0)
#define MFMA32(a, b, c) __builtin_amdgcn_mfma_f32_32x32x16_bf16((a), (b), (c), 0, 0, 0)

DI void pv(f32x16* o, int vb, bf16x8 pa0, bf16x8 pa1, bf16x8 pa2, bf16x8 pa3) {
#pragma unroll
    for (int d0 = 0; d0 < 2; ++d0) { s16x4 lo[4], hi[4];
#pragma unroll
        for (int ks = 0; ks < 4; ++ks) {
            asm volatile("ds_read_b64_tr_b16 %0,%1 offset:%c2" : "=&v"(lo[ks]) : "v"(vb), "i"(d0 * 4096 + ks * 1024) : "memory");
            asm volatile("ds_read_b64_tr_b16 %0,%1 offset:%c2" : "=&v"(hi[ks]) : "v"(vb), "i"(d0 * 4096 + ks * 1024 + 512) : "memory"); }
        asm volatile("s_waitcnt lgkmcnt(0)" ::: "memory"); SBAR();
#define PK(k) (bf16x8){lo[k][0], lo[k][1], lo[k][2], lo[k][3], hi[k][0], hi[k][1], hi[k][2], hi[k][3]}
        o[d0] = MFMA32(pa0, PK(0), o[d0]); o[d0] = MFMA32(pa1, PK(1), o[d0]); o[d0] = MFMA32(pa2, PK(2), o[d0]); o[d0] = MFMA32(pa3, PK(3), o[d0]);
#undef PK
    }
}
DI bf16x8 pack8(const f32x16& p, int b) { u32x4 w; w.x = cvt_pk_bf16(p[b], p[b + 1]); w.y = cvt_pk_bf16(p[b + 2], p[b + 3]); w.z = cvt_pk_bf16(p[b + 4], p[b + 5]); w.w = cvt_pk_bf16(p[b + 6], p[b + 7]); return __builtin_bit_cast(bf16x8, w); }

DI int t5_bucket(int n) {
    if (n < 16) return n;
    int b = 16; const int th[15] = {19, 21, 24, 27, 31, 35, 40, 46, 52, 59, 67, 77, 87, 99, 113};
#pragma unroll
    for (int i = 0; i < 15; ++i) b += (n >= th[i]) ? 1 : 0;
    return b;
}

template <int KIND>
DI void attn_unit(LAS unsigned char* lds, const bf16_t* Q, int qp, const bf16_t* Kg, const bf16_t* Vg, int kvp, bf16_t* O, int op, int h, int b, int qb, const unsigned char* BM, const float* relb) {
    const int tid = opaque_tid(), lane = tid & 63, r32 = lane & 31, hi = lane >> 5; const int wid = __builtin_amdgcn_readfirstlane(tid >> 6);
    const int qrow0 = qb < 0 ? 0 : ROW0 + SEQ * b + 256 * qb;
    const int qrow = qrow0 + 32 * wid + r32;
    const int qposw = qb < 0 ? 32 * wid - MROW : 16 + 256 * qb + 32 * wid;
    const int qpos = qposw + r32;
    bf16x8 qr[4];
#pragma unroll
    for (int d0 = 0; d0 < 4; ++d0) qr[d0] = *(const bf16x8*)(Q + (size_t)qrow * qp + h * 64 + d0 * 16 + hi * 8);
    LAS float* TB = (LAS float*)(lds + A_TB);
    LAS float* wsf = (LAS float*)(lds + A_WS) + wid * 64;
    volatile LAS int* flg = (volatile LAS int*)(lds + A_FLG);
    if (KIND == 0) { if (tid < 128) TB[tid] = relb[t5_bucket(tid) * 8 + h] * LOG2E; }
    else { if (tid < 16) flg[tid] = 0; }
    const int nreal = qb < 0 ? 0 : 4 * (qb + 1);
    const int nt = nreal + 1;
#define TILE_RT(it) (KIND == 0 ? (it) - 1 : ((it) < nreal ? nreal - 1 - (it) : -1))
#define TILE_ROW0(rt) ((rt) < 0 ? 192 : ROW0 + SEQ * b + 64 * (rt))
    const bf16_t* kb_ = Kg + h * 64 + wid * 8 + (size_t)lane * kvp;
    const bf16_t* vb_ = Vg + h * 64 + (wid >> 2) * 32 + (lane & 3) * 8 + (size_t)(16 * (wid & 3) + (lane >> 2)) * kvp;
    u32x4 kreg, vreg;
    { const int row0 = TILE_ROW0(TILE_RT(0)); kreg = *(const u32x4*)(kb_ + (size_t)row0 * kvp); vreg = *(const u32x4*)(vb_ + (size_t)row0 * kvp); }
    float mrun = -INFINITY, lsum = 0.f, carry = 0.f; bool wdone = false;
    f32x16 o[2]; o[0] = f32x16{}; o[1] = f32x16{};
    const unsigned ldsb = (unsigned)(size_t)lds;
    const int vlane = ((lane >> 4) & 1) * 32 + (lane & 3) * 8 + (4 * hi + ((lane & 15) >> 2)) * 64;
    for (int it = 0; it < nt; ++it) {
        const int slot = it & 1;
        *(LAS u32x4*)(lds + A_K + slot * 8192 + wid * 1024 + lane * 16) = kreg;
        *(LAS u32x4*)(lds + A_V + slot * 8192 + wid * 1024 + lane * 16) = vreg;
        __syncthreads();
        if (KIND == 1 && it > 0) { int all = 1;
#pragma unroll
            for (int w = 0; w < 8; ++w) all &= flg[((it - 1) & 1) * 8 + w];
            if (all) break; }
        const int rt = TILE_RT(it);
        if (it + 1 < nt) { const int row0 = TILE_ROW0(TILE_RT(it + 1)); kreg = *(const u32x4*)(kb_ + (size_t)row0 * kvp); vreg = *(const u32x4*)(vb_ + (size_t)row0 * kvp); }
        const int kpos0 = rt < 0 ? -48 : 16 + 64 * rt;
        bool active = true;
        if (KIND == 1) active = !wdone && (kpos0 < qposw + 31);
        unsigned wlo = 0u, whi = 0u;
        if (KIND == 0) {
            if (rt >= 0) { const u32x2 w = *(const u32x2*)(BM + (size_t)(SEQ * b + 256 * qb + 32 * wid + r32) * 512 + 8 * rt); wlo = w.x; whi = w.y; }
            else { const int top = qpos < 15 ? qpos : 15; whi = top < 0 ? 0u : (((2u << top) - 1u) << 16); }
        }
        if (active) {
            f32x16 p0 = f32x16{}, p1 = f32x16{};
            { const LAS unsigned char* kb = lds + A_K + slot * 8192 + hi * 1024 + r32 * 16;
#pragma unroll
              for (int d0 = 0; d0 < 4; ++d0) { const bf16x8 b0 = *(const LAS bf16x8*)(kb + d0 * 2048), b1 = *(const LAS bf16x8*)(kb + d0 * 2048 + 512);
                  p0 = MFMA32(b0, qr[d0], p0); p1 = MFMA32(b1, qr[d0], p1); } }
            if (KIND == 0) {
                if (qposw - (kpos0 + 63) >= 127) { const float c = TB[127];
#pragma unroll
                    for (int r = 0; r < 16; ++r) { p0[r] += c; p1[r] += c; } }
                else {
#pragma unroll
                    for (int r = 0; r < 16; ++r) { int rel = qpos - (kpos0 + crow(r, hi)); int i0 = rel < 0 ? 0 : (rel > 127 ? 127 : rel); rel -= 32; int i1 = rel < 0 ? 0 : (rel > 127 ? 127 : rel);
                        p0[r] += TB[i0]; p1[r] += TB[i1]; } }
                const unsigned ml = wlo >> (4 * hi), mh = whi >> (4 * hi);
#pragma unroll
                for (int r = 0; r < 16; ++r) { const unsigned bit = 1u << ((r & 3) + 8 * (r >> 2)); p0[r] = (ml & bit) ? p0[r] : -INFINITY; p1[r] = (mh & bit) ? p1[r] : -INFINITY; }
                float mx = -INFINITY;
#pragma unroll
                for (int r = 0; r < 16; ++r) mx = fmaxf(mx, fmaxf(p0[r], p1[r]));
                mx = fmaxf(mx, __shfl_xor(mx, 32));
                const float mnew = fmaxf(mrun, mx), msafe = (mnew == -INFINITY) ? 0.f : mnew;
                const float alpha = __builtin_amdgcn_exp2f(mrun - msafe);
                mrun = mnew;
                float ps = 0.f;
#pragma unroll
                for (int r = 0; r < 16; ++r) { p0[r] = __builtin_amdgcn_exp2f(p0[r] - msafe); p1[r] = __builtin_amdgcn_exp2f(p1[r] - msafe); ps += p0[r] + p1[r]; }
                lsum = lsum * alpha + ps;
                if (hi == 0) wsf[r32] = alpha;
                LDS_WAIT(); asm volatile("" ::: "memory");
#pragma unroll
                for (int r = 0; r < 16; ++r) { const float a = wsf[crow(r, hi)]; o[0][r] *= a; o[1][r] *= a; }
            } else {
                float L0[16], L1[16];
#pragma unroll
                for (int r = 0; r < 16; ++r) {
                    const int k0 = kpos0 + crow(r, hi), k1 = k0 + 32;
                    { const float z = p0[r], sp = fmaxf(z, 0.f) + LN2 * __builtin_amdgcn_logf(1.0f + __builtin_amdgcn_exp2f(-fabsf(z) * LOG2E)); const bool v = (k0 < qpos) && (k0 >= 0); L0[r] = v ? -sp : 0.f; p0[r] = v ? z - sp : -INFINITY; }
                    { const float z = p1[r], sp = fmaxf(z, 0.f) + LN2 * __builtin_amdgcn_logf(1.0f + __builtin_amdgcn_exp2f(-fabsf(z) * LOG2E)); const bool v = (k1 < qpos) && (k1 >= 0); L1[r] = v ? -sp : 0.f; p1[r] = v ? z - sp : -INFINITY; }
                }
                float g0[4], g1[4], og0[4], og1[4];
#pragma unroll
                for (int i = 0; i < 4; ++i) { g0[i] = (L0[4 * i] + L0[4 * i + 1]) + (L0[4 * i + 2] + L0[4 * i + 3]); g1[i] = (L1[4 * i] + L1[4 * i + 1]) + (L1[4 * i + 2] + L1[4 * i + 3]); og0[i] = __shfl_xor(g0[i], 32); og1[i] = __shfl_xor(g1[i], 32); }
                float sg1[4], sg0[4]; float run = 0.f;
#pragma unroll
                for (int i = 3; i >= 0; --i) { sg1[i] = run + (hi == 0 ? og1[i] : 0.f); run += g1[i] + og1[i]; }
#pragma unroll
                for (int i = 3; i >= 0; --i) { sg0[i] = run + (hi == 0 ? og0[i] : 0.f); run += g0[i] + og0[i]; }
#pragma unroll
                for (int i = 0; i < 4; ++i) {
                    float e = carry + sg0[i];
#pragma unroll
                    for (int j = 3; j >= 0; --j) { p0[4 * i + j] = __builtin_amdgcn_exp2f((p0[4 * i + j] + e) * LOG2E); e += L0[4 * i + j]; }
                    e = carry + sg1[i];
#pragma unroll
                    for (int j = 3; j >= 0; --j) { p1[4 * i + j] = __builtin_amdgcn_exp2f((p1[4 * i + j] + e) * LOG2E); e += L1[4 * i + j]; }
                }
                carry += run;
                wdone = __all(carry < -104.0f);
            }
            const bf16x8 pa0 = pack8(p0, 0), pa1 = pack8(p0, 8), pa2 = pack8(p1, 0), pa3 = pack8(p1, 8);
            SBAR();
            pv(o, (int)(ldsb + A_V + slot * 8192) + vlane, pa0, pa1, pa2, pa3);
        }
        if (KIND == 1 && lane == 0) flg[(it & 1) * 8 + wid] = wdone ? 1 : 0;
    }
    float rli[16];
    if (KIND == 0) {
        lsum += __shfl_xor(lsum, 32);
        if (hi == 0) wsf[32 + r32] = lsum;
        LDS_WAIT(); asm volatile("" ::: "memory");
#pragma unroll
        for (int r = 0; r < 16; ++r) { const float l = wsf[32 + crow(r, hi)]; rli[r] = l > 0.f ? __builtin_amdgcn_rcpf(l) : 0.f; }
    } else {
#pragma unroll
        for (int r = 0; r < 16; ++r) rli[r] = 1.f;
    }
    { LAS bf16_t* stg = (LAS bf16_t*)(lds + A_OST) + wid * 2048;
#pragma unroll
      for (int r = 0; r < 16; ++r) { const int orow = crow(r, hi);
#pragma unroll
          for (int d0 = 0; d0 < 2; ++d0) stg[orow * 64 + d0 * 32 + r32] = (bf16_t)(cvt_pk_bf16(o[d0][r] * rli[r], 0.f) & 0xffffu); }
      LDS_WAIT(); asm volatile("" ::: "memory");
      bf16_t* Ow = O + (size_t)(qrow0 + 32 * wid) * op + h * 64;
#pragma unroll
      for (int i = 0; i < 4; ++i) { const int row = i * 8 + (lane >> 3), ch = lane & 7; const u32x4 v = *(const LAS u32x4*)(stg + row * 64 + ch * 8); *(u32x4*)(Ow + (size_t)row * op + ch * 8) = v; } }
    __syncthreads();
#undef TILE_RT
#undef TILE_ROW0
}
}
DI size_t sc_row_off(int b, int t) { const int Q = t >> 8; return (size_t)b * SC_BATCH + (size_t)32768 * Q * (Q + 1) + (size_t)(t & 255) * 256 * (Q + 1); }
DI void indexer_item(int item, const bf16_t* IQ, const bf16_t* IK, const float* IW, unsigned short* SC, int lane) {
    const int b = item / 576; int r = item % 576;
    int g = 0; while (r >= 8 * (g + 1) * (g + 2)) ++g;
    r -= 8 * g * (g + 1);
    const int qblk = 16 * g + r / (g + 1), kc = r % (g + 1);
    const int r32 = lane & 31, hi = lane >> 5;
    const int t = 32 * qblk + r32, row = ROW0 + SEQ * b + t;
    bf16x8 qf[8][4]; float w[8];
#pragma unroll
    for (int h = 0; h < 8; ++h) {
#pragma unroll
        for (int s = 0; s < 4; ++s) qf[h][s] = *(const bf16x8*)(IQ + (size_t)row * 512 + h * 64 + s * 16 + hi * 8);
        w[h] = IW[(size_t)row * 8 + h]; }
    unsigned short* scrow = SC + sc_row_off(b, t);
    const int kt1 = (kc * 16 + 15) < qblk ? (kc * 16 + 15) : qblk;
    for (int kt = kc * 16; kt <= kt1; ++kt) {
        const int krow = ROW0 + SEQ * b + 32 * kt + r32;
        bf16x8 kf[4];
#pragma unroll
        for (int s = 0; s < 4; ++s) kf[s] = *(const bf16x8*)(IK + (size_t)krow * 64 + s * 16 + hi * 8);
        f32x16 sc = f32x16{};
#pragma unroll
        for (int h = 0; h < 8; ++h) { f32x16 a = f32x16{};
#pragma unroll
            for (int s = 0; s < 4; ++s) a = __builtin_amdgcn_mfma_f32_32x32x16_bf16(kf[s], qf[h][s], a, 0, 0, 0);
#pragma unroll
            for (int i = 0; i < 16; ++i) sc[i] += fmaxf(a[i], 0.f) * w[h]; }
#pragma unroll
        for (int gq = 0; gq < 4; ++gq) { unsigned v[4];
#pragma unroll
            for (int j = 0; j < 4; ++j) { float f = sc[4 * gq + j] * 4096.0f + 32768.0f; f = fminf(fmaxf(f, 0.f), 65535.f); v[j] = (unsigned)__float2int_rn(f); }
            u32x2 o; o.x = v[0] | (v[1] << 16); o.y = v[2] | (v[3] << 16);
            *(u32x2*)(scrow + 32 * kt + 8 * gq + 4 * hi) = o; }
    }
}

DI void select_row(int b, int t, const unsigned short* SC, unsigned char* BM, LAS unsigned* hist, int lane) {
    unsigned char* bm = BM + (size_t)(SEQ * b + t) * 512;
    const int n = t + 1;
    if (n <= 240) {
#pragma unroll
        for (int j = 0; j < 8; ++j) { const int k0 = (j * 64 + lane) * 8; int c = n - k0; c = c < 0 ? 0 : (c > 8 ? 8 : c); bm[j * 64 + lane] = (unsigned char)((1u << c) - 1u); }
        return;
    }
    const unsigned short* row = SC + sc_row_off(b, t);
    const int pitch = 256 * ((t >> 8) + 1);
    unsigned key[8][8];
#pragma unroll
    for (int j = 0; j < 8; ++j) { const int k0 = (j * 64 + lane) * 8; u32x4 v = {0u, 0u, 0u, 0u}; if (k0 < pitch) v = *(const u32x4*)(row + k0);
#pragma unroll
        for (int e = 0; e < 4; ++e) { key[j][2 * e] = v[e] & 0xffffu; key[j][2 * e + 1] = v[e] >> 16; } }
    unsigned thr_hi = 0, need = 240;
#pragma unroll 1
    for (int pass = 0; pass < 2; ++pass) {
#pragma unroll
        for (int i = 0; i < 4; ++i) hist[lane * 4 + i] = 0u;
        LDS_WAIT(); asm volatile("" ::: "memory");
#pragma unroll
        for (int j = 0; j < 8; ++j)
#pragma unroll
            for (int e = 0; e < 8; ++e) { const int k = (j * 64 + lane) * 8 + e; const unsigned kv = key[j][e];
                const bool use = (k <= t) && (pass == 0 || (kv >> 8) == thr_hi);
                if (use) __hip_atomic_fetch_add(&hist[pass == 0 ? (kv >> 8) : (kv & 255u)], 1u, __ATOMIC_RELAXED, __HIP_MEMORY_SCOPE_WORKGROUP); }
        LDS_WAIT(); asm volatile("" ::: "memory");
        unsigned c[4], s = 0;
#pragma unroll
        for (int i = 0; i < 4; ++i) { c[i] = hist[lane * 4 + i]; s += c[i]; }
        unsigned suf = s;
#pragma unroll
        for (int o = 1; o < 64; o <<= 1) { const unsigned v = __shfl_down(suf, o); if (lane + o < 64) suf += v; }
        unsigned above = suf - s; int bin = -1; unsigned ab = 0;
#pragma unroll
        for (int i = 3; i >= 0; --i) { if (bin < 0 && above < need && above + c[i] >= need) { bin = lane * 4 + i; ab = above; } above += c[i]; }
        const unsigned long long m = __ballot(bin >= 0); const int src = (int)__builtin_ctzll(m ? m : 1ull);
        const unsigned fb = (unsigned)__shfl(bin, src), fa = __shfl(ab, src);
        if (pass == 0) { thr_hi = fb; need -= fa; } else { thr_hi = (thr_hi << 8) | fb; need -= fa; }
        LDS_WAIT(); asm volatile("" ::: "memory");
    }
    const unsigned thr = thr_hi;
    unsigned eqbase = 0;
#pragma unroll
    for (int j = 0; j < 8; ++j) {
        unsigned ce = 0;
#pragma unroll
        for (int e = 0; e < 8; ++e) { const int k = (j * 64 + lane) * 8 + e; ce += (k <= t && key[j][e] == thr) ? 1u : 0u; }
        unsigned inc = ce;
#pragma unroll
        for (int o = 1; o < 64; o <<= 1) { const unsigned v = __shfl_up(inc, o); if (lane >= o) inc += v; }
        unsigned rank = eqbase + inc - ce;
        eqbase += __shfl(inc, 63);
        unsigned bits = 0;
#pragma unroll
        for (int e = 0; e < 8; ++e) { const int k = (j * 64 + lane) * 8 + e; const unsigned kv = key[j][e]; bool sel = false;
            if (k <= t) { if (kv > thr) sel = true; else if (kv == thr) { sel = rank < need; ++rank; } }
            bits |= sel ? (1u << e) : 0u; }
        bm[j * 64 + lane] = (unsigned char)bits;
    }
}

constexpr int RL_K = 0, RL_V = 32768;
DI void ret_state_unit(LAS unsigned char* lds, int b, int h, int fs, const bf16_t* BKZ, const bf16_t* BV, bf16_t* RS) {
    const int tid = opaque_tid(), lane = tid & 63, hi = lane >> 5, r32 = lane & 31; const int wid = __builtin_amdgcn_readfirstlane(tid >> 6);
    const int db = wid & 3, fb = wid >> 2;
    const float g = exp2f(128.0f * gamma_log2(h));
    f32x16 S = f32x16{};
    const unsigned ldsb = (unsigned)(size_t)lds;
    const int vlane = ((lane >> 4) & 1) * 32 + (lane & 3) * 8 + (4 * hi + ((lane & 15) >> 2)) * 64;
    u32x4 kr[4], vr[2];
#define RET_LOADC(cc_) do { const int row0_ = (cc_) < 0 ? 128 : ROW0 + SEQ * b + 128 * (cc_); \
        _Pragma("unroll") for (int i = 0; i < 4; ++i) { const int idx = tid + 512 * i, piece = idx >> 6, l = idx & 63; const int e = 16 * (piece & 7) + (l >> 2), d = 32 * (piece >> 3) + 8 * (l & 3); \
            kr[i] = *(const u32x4*)(BKZ + (size_t)(row0_ + e) * 512 + 128 * h + d); } \
        _Pragma("unroll") for (int i = 0; i < 2; ++i) { const int idx = tid + 512 * i, piece = idx >> 6, l = idx & 63; const int e = 16 * (piece & 7) + (l >> 2), f = 32 * (piece >> 3) + 8 * (l & 3); \
            vr[i] = *(const u32x4*)(BV + (size_t)(row0_ + e) * 1024 + 256 * h + 64 * fs + f); } } while (0)
    RET_LOADC(-1);
    for (int cc = -1; cc < 31; ++cc) {
#pragma unroll
        for (int i = 0; i < 4; ++i) *(LAS u32x4*)(lds + RL_K + (tid + 512 * i) * 16) = kr[i];
#pragma unroll
        for (int i = 0; i < 2; ++i) *(LAS u32x4*)(lds + RL_V + (tid + 512 * i) * 16) = vr[i];
        __syncthreads();
        if (cc + 1 < 31) RET_LOADC(cc + 1);
        f32x16 kv = f32x16{};
#pragma unroll
        for (int ks = 0; ks < 8; ++ks) { s16x4 al, ah, bl, bh;
            const int ka = (int)ldsb + RL_K + (db * 8 + ks) * 1024 + vlane, va = (int)ldsb + RL_V + (fb * 8 + ks) * 1024 + vlane;
            asm volatile("ds_read_b64_tr_b16 %0,%1" : "=&v"(al) : "v"(ka) : "memory");
            asm volatile("ds_read_b64_tr_b16 %0,%1 offset:512" : "=&v"(ah) : "v"(ka) : "memory");
            asm volatile("ds_read_b64_tr_b16 %0,%1" : "=&v"(bl) : "v"(va) : "memory");
            asm volatile("ds_read_b64_tr_b16 %0,%1 offset:512" : "=&v"(bh) : "v"(va) : "memory");
            asm volatile("s_waitcnt lgkmcnt(0)" ::: "memory"); __builtin_amdgcn_sched_barrier(0);
            const bf16x8 A = {al[0], al[1], al[2], al[3], ah[0], ah[1], ah[2], ah[3]}, B = {bl[0], bl[1], bl[2], bl[3], bh[0], bh[1], bh[2], bh[3]};
            kv = __builtin_amdgcn_mfma_f32_32x32x16_bf16(A, B, kv, 0, 0, 0); }
#pragma unroll
        for (int i = 0; i < 16; ++i) S[i] = S[i] * g + kv[i];
        bf16_t* rp = RS + ((((size_t)(b * 4 + h) * 32 + (cc + 1)) * 256) + 64 * fs + 32 * fb + r32) * 128 + 32 * db + 4 * hi;
#pragma unroll
        for (int gq = 0; gq < 4; ++gq) { u32x2 o; o.x = cvt_pk_bf16(S[4 * gq], S[4 * gq + 1]); o.y = cvt_pk_bf16(S[4 * gq + 2], S[4 * gq + 3]); *(u32x2*)(rp + 8 * gq) = o; }
        __syncthreads();
    }
}

constexpr int RO_K = 0, RO_V = 32768, RO_X = 98304;
DI void ret_out_unit(LAS unsigned char* lds, int b, int h, int c, const bf16_t* BQ, const bf16_t* BKZ, const bf16_t* BV, const bf16_t* RS, bf16_t* CAT, const float* gng) {
    const int tid = opaque_tid(), lane = tid & 63, hi = lane >> 5, r32 = lane & 31; const int wid = __builtin_amdgcn_readfirstlane(tid >> 6);
    const int rb = wid & 3, fh = wid >> 2;
    const int row0 = c < 0 ? 128 : ROW0 + SEQ * b + 128 * c;
    const float lg = gamma_log2(h);
#pragma unroll 1
    for (int i = 0; i < 4; ++i) { const int idx = tid + 512 * i, et = idx >> 10, rem = idx & 1023, dc = rem >> 6, e = rem & 63;
        *(LAS u32x4*)(lds + RO_K + et * 16384 + dc * 1024 + e * 16) = *(const u32x4*)(BKZ + (size_t)(row0 + 64 * et + e) * 512 + 128 * h + 8 * dc); }
    asm volatile("" ::: "memory");
#pragma unroll 2
    for (int i = 0; i < 8; ++i) { const int idx = tid + 512 * i, et = idx >> 11, rem = idx & 2047, piece = rem >> 6, l = rem & 63; const int e = 16 * (piece & 3) + (l >> 2), f = 32 * (piece >> 2) + 8 * (l & 3);
        *(LAS u32x4*)(lds + RO_V + et * 32768 + piece * 1024 + l * 16) = *(const u32x4*)(BV + (size_t)(row0 + 64 * et + e) * 1024 + 256 * h + f); if (i == 3) asm volatile("" ::: "memory"); }
    asm volatile("" ::: "memory");
    bf16x8 qf[8];
#pragma unroll
    for (int s = 0; s < 8; ++s) qf[s] = *(const bf16x8*)(BQ + (size_t)(row0 + 32 * rb + r32) * 512 + 128 * h + 16 * s + 8 * hi);
    f32x16 o[4];
#pragma unroll
    for (int fb = 0; fb < 4; ++fb) o[fb] = f32x16{};
    if (c >= 0) {
        const bf16_t* rs = RS + (((size_t)(b * 4 + h) * 32 + c) * 256 + 128 * fh + r32) * 128 + 8 * hi;
#pragma unroll
        for (int fb = 0; fb < 4; ++fb) {
#pragma unroll
            for (int s = 0; s < 8; ++s) { const bf16x8 rf = *(const bf16x8*)(rs + (size_t)(32 * fb) * 128 + 16 * s); o[fb] = __builtin_amdgcn_mfma_f32_32x32x16_bf16(qf[s], rf, o[fb], 0, 0, 0); }
            asm volatile("" ::: "memory"); }
#pragma unroll
        for (int r = 0; r < 16; ++r) { const float xi = exp2f((float)(32 * rb + att::crow(r, hi) + 1) * lg);
#pragma unroll
            for (int fb = 0; fb < 4; ++fb) o[fb][r] *= xi; }
    }
    __syncthreads();
    const unsigned ldsb = (unsigned)(size_t)lds;
    const int vlane = ((lane >> 4) & 1) * 32 + (lane & 3) * 8 + (4 * hi + ((lane & 15) >> 2)) * 64;
    const int n = 32 * rb + r32;
    const float rowfac = exp2f((float)(n - 127) * lg);
    const int net = rb >= 2 ? 2 : 1;
    for (int et = 0; et < net; ++et) {
        f32x16 p0 = f32x16{}, p1 = f32x16{};
        const LAS unsigned char* kb = lds + RO_K + et * 16384 + hi * 1024 + r32 * 16;
#pragma unroll
        for (int s = 0; s < 8; ++s) { const bf16x8 b0 = *(const LAS bf16x8*)(kb + s * 2048), b1 = *(const LAS bf16x8*)(kb + s * 2048 + 512);
            p0 = __builtin_amdgcn_mfma_f32_32x32x16_bf16(b0, qf[s], p0, 0, 0, 0); p1 = __builtin_amdgcn_mfma_f32_32x32x16_bf16(b1, qf[s], p1, 0, 0, 0); }
#pragma unroll
        for (int r = 0; r < 16; ++r) { const int e0 = 64 * et + att::crow(r, hi); p0[r] = (e0 <= n) ? p0[r] * rowfac : 0.f; p1[r] = (e0 + 32 <= n) ? p1[r] * rowfac : 0.f; }
        const bf16x8 pa[4] = {att::pack8(p0, 0), att::pack8(p0, 8), att::pack8(p1, 0), att::pack8(p1, 8)};
        __builtin_amdgcn_sched_barrier(0);
#pragma unroll
        for (int fb = 0; fb < 4; ++fb) { s16x4 lo[4], hh[4];
            const int va = (int)ldsb + RO_V + et * 32768 + ((4 * fh + fb) * 4) * 1024 + vlane;
#pragma unroll
            for (int ks = 0; ks < 4; ++ks) {
                asm volatile("ds_read_b64_tr_b16 %0,%1 offset:%c2" : "=&v"(lo[ks]) : "v"(va), "i"(ks * 1024) : "memory");
                asm volatile("ds_read_b64_tr_b16 %0,%1 offset:%c2" : "=&v"(hh[ks]) : "v"(va), "i"(ks * 1024 + 512) : "memory"); }
            asm volatile("s_waitcnt lgkmcnt(0)" ::: "memory"); __builtin_amdgcn_sched_barrier(0);
#pragma unroll
            for (int ks = 0; ks < 4; ++ks) { const bf16x8 vf = {lo[ks][0], lo[ks][1], lo[ks][2], lo[ks][3], hh[ks][0], hh[ks][1], hh[ks][2], hh[ks][3]};
                o[fb] = __builtin_amdgcn_mfma_f32_32x32x16_bf16(pa[ks], vf, o[fb], 0, 0, 0); } }
    }
    LAS float* X = (LAS float*)(lds + RO_X);
#pragma unroll
    for (int r = 0; r < 16; ++r) { float a = 0.f, q = 0.f;
#pragma unroll
        for (int fb = 0; fb < 4; ++fb) { a += o[fb][r]; q += o[fb][r] * o[fb][r]; }
#pragma unroll
        for (int m = 1; m < 32; m <<= 1) { a += __shfl_xor(a, m); q += __shfl_xor(q, m); }
        if (r32 == 0) { LAS float* xp = X + (((rb * 2 + fh) * 32) + att::crow(r, hi)) * 2; xp[0] = a; xp[1] = q; } }
    __syncthreads();
    bf16_t* cat = CAT + (size_t)(row0 + 32 * rb) * 1536 + 512 + 256 * h + 128 * fh + r32;
#pragma unroll
    for (int r = 0; r < 16; ++r) { const int nr = att::crow(r, hi);
        const LAS float* xa = X + (((rb * 2 + 0) * 32) + nr) * 2; const LAS float* xb = X + (((rb * 2 + 1) * 32) + nr) * 2;
        const float sum = xa[0] + xb[0], sq = xa[1] + xb[1]; const float mu = sum * (1.0f / 256.0f); float var = sq * (1.0f / 256.0f) - mu * mu; var = var < 0.f ? 0.f : var;
        const float rstd = 1.0f / sqrtf(var + EPS);
#pragma unroll
        for (int fb = 0; fb < 4; ++fb) { bf16_t* p = cat + (size_t)nr * 1536 + 32 * fb; const float gate = bf2f(*p); const float sg = gate / (1.0f + __expf(-gate));
            const float v = (o[fb][r] - mu) * rstd * gng[256 * h + 128 * fh + 32 * fb + r32] * sg; *p = (bf16_t)(cvt_pk_bf16(v, 0.f) & 0xffffu); }
        asm volatile("" ::: "memory"); }
    __syncthreads();
}
#ifndef PH_LO
#define PH_LO 0
#endif
#ifndef PH_HI
#define PH_HI 14
#endif
__global__ void __launch_bounds__(NWAVES * 64, 2) fwd_kernel(Params P) {
    extern __shared__ __attribute__((aligned(16))) unsigned char lds_raw[];
    LAS unsigned char* lds = (LAS unsigned char*)lds_raw;
    volatile LAS unsigned* MISC = (volatile LAS unsigned*)(lds + MISC_OFF);
    const int tid = threadIdx.x, lane = tid & 63, wave = __builtin_amdgcn_readfirstlane(tid >> 6);
    const int G = gridDim.x; const int bx = blockIdx.x; const int vcu = (G % 8 == 0) ? (bx % 8) * (G / 8) + bx / 8 : bx;
    const int gw = vcu * NWAVES + wave, NGW = G * NWAVES;
    unsigned char* ws = P.ws; unsigned char* dob = (unsigned char*)P.out;
    gu32* ctl = (gu32*)(ws + WS_CTL);
    for (int u = tid; u < (LDS_BYTES - LDSCTL_OFF) / 4; u += NWAVES * 64) ((LAS unsigned*)(lds + LDSCTL_OFF))[u] = 0u;
    __syncthreads();
    XcdBarrier bar = xcd_barrier_post((unsigned*)(ctl + CW_BAR), MISC + 8);

    float* SSQ = (float*)(ws + WS_SSQ); float* H = (float*)(ws + WS_H); bf16_t* HB = (bf16_t*)(ws + WS_HB);
    bf16_t* AK = (bf16_t*)(ws + WS_AK); bf16_t* AV = (bf16_t*)(ws + WS_AV); bf16_t* IQ = (bf16_t*)(ws + WS_IQ);
    unsigned short* SC = (unsigned short*)(ws + WS_SC); bf16_t* CAT = (bf16_t*)(ws + WS_CAT);
    bf16_t* BQ = (bf16_t*)(ws + WS_BQ); bf16_t* BKZ = (bf16_t*)(ws + WS_BKZ); bf16_t* BV = (bf16_t*)(ws + WS_BV);
    bf16_t* ACT = (bf16_t*)(ws + WS_BIG); bf16_t* Q1 = (bf16_t*)(ws + WS_Q1); bf16_t* K1 = (bf16_t*)(ws + WS_K1); bf16_t* V1 = (bf16_t*)(ws + WS_V1);
    bf16_t* WIN0 = (bf16_t*)(dob + DO_WIN0); bf16_t* RS = (bf16_t*)(dob + DO_RS);
    bf16_t* WOUT0 = (bf16_t*)(dob + DO_WOUT0); bf16_t* WUG0 = (bf16_t*)(dob + DO_WUG0); bf16_t* WDN0 = (bf16_t*)(dob + DO_WDN0);
    bf16_t* WIN1 = (bf16_t*)(dob + DO_WIN1); bf16_t* WOUT1 = (bf16_t*)(dob + DO_WOUT1); bf16_t* WUG1 = (bf16_t*)(dob + DO_WUG1); bf16_t* WDN1 = (bf16_t*)(dob + DO_WDN1);
    unsigned char* BM = dob + DO_BM; f32x2* ROT = (f32x2*)(dob + DO_ROT); bf16_t* IK = (bf16_t*)(dob + DO_IK); float* IW = (float*)(dob + DO_IW);

#define IN(k) (PH_LO <= (k) && (k) < PH_HI)
#define SEAM(k) do { if (IN(k) && IN((k) + 1)) xcd_barrier(bar); } while (0)

    if (IN(0)) {
        LAS float* scr = (LAS float*)(lds + wave * 16384);
        for (int it = gw; it < 16 * (N0 / 32); it += NGW) transpose_item<1>(P.win0, nullptr, 1024, N0, WIN0, P.nmix, scr, it, lane);
        for (int e = vcu * 512 + tid; e < 4112 * 64; e += G * 512) { const int pos = e >> 6, i = e & 63;
            const float inv = 1.0f / powf(10000.0f, (float)i * (1.0f / 64.0f)); const float ang = (float)pos * inv;
            const double rev = (double)ang * 0.15915494309189535; const float fr = (float)(rev - floor(rev));
            ROT[e] = (f32x2){__builtin_amdgcn_cosf(fr), __builtin_amdgcn_sinf(fr)}; }
        for (int r = gw; r < RT; r += NGW) { const float* src = h0_row(P, r);
            f32x4 v[4]; float s = 0.f;
#pragma unroll
            for (int j = 0; j < 4; ++j) { v[j] = src ? ((const f32x4*)src)[lane + 64 * j] : (f32x4){0.f, 0.f, 0.f, 0.f}; s += (v[j][0] * v[j][0] + v[j][1] * v[j][1]) + (v[j][2] * v[j][2] + v[j][3] * v[j][3]); }
            s = wave_sum(s);
#pragma unroll
            for (int j = 0; j < 4; ++j) { u32x2 o; o.x = cvt_pk_bf16(v[j][0], v[j][1]); o.y = cvt_pk_bf16(v[j][2], v[j][3]); ((u32x2*)(HB + (size_t)r * DM))[lane + 64 * j] = o; }
            if (lane < 16) SSQ[(size_t)r * 16 + lane] = lane == 0 ? s : 0.f; }
    }
    SEAM(0);
    if (IN(1)) {
        pg8::Gemm g{HB, WIN0, 1024}; pg8::SchedPlain S; S.init(NMT, N0 / 256, G, bx, 0);
        EpiG0 E{CAT, AK, AV, IQ, IK, BQ, BKZ, BV, IW, SSQ, ROT, (LAS float*)(lds + LDSX_OFF + 4096)};
        pg8::gemm_phase(lds, g, S, E);
    }
    SEAM(1);
    if (IN(2)) {
        const int nstate = G >= 128 ? 64 : 0;
        if (vcu < nstate) { ret_state_unit(lds, vcu >> 4, (vcu >> 2) & 3, vcu & 3, BKZ, BV, RS); }
        else {
            if (nstate == 0) for (int u = vcu; u < 64; u += G) ret_state_unit(lds, u >> 4, (u >> 2) & 3, u & 3, BKZ, BV, RS);
            const int iw = (vcu - nstate) * NWAVES + wave, niw = (G - nstate) * NWAVES;
            for (int item = iw; item < 576 * NB; item += niw) indexer_item(item, IQ, IK, IW, SC, lane);
        }
    }
    SEAM(2);
    if (IN(3)) {
#ifndef NO_RETOUT
        for (int u = vcu; u < 516; u += G) { const int ub = u < 512 ? u >> 7 : 0, uh = u < 512 ? (u >> 5) & 3 : u - 512, uc = u < 512 ? (u & 31) : -1; ret_out_unit(lds, ub, uh, uc, BQ, BKZ, BV, RS, CAT, P.gng); }
#endif
#ifndef NO_SELECT
        LAS unsigned* hist = (LAS unsigned*)(lds + wave * 1024);
        for (int r = gw; r < NB * SEQ; r += NGW) select_row(r >> 12, r & (SEQ - 1), SC, BM, hist, lane);
#endif
    }
    SEAM(3);
    if (IN(4)) {
        LAS float* scr = (LAS float*)(lds + wave * 16384);
        constexpr int I0 = 24 * 32, I1 = 16 * 176, I2 = 44 * 32, I3 = 16 * 96, I4 = 16 * 32;
        for (int it = gw; it < I0 + 2 * I1 + 2 * I2 + I3 + I4; it += NGW) { int r = it;
            if (r < I0) { transpose_item<0>(P.wout0, nullptr, 1536, 1024, WOUT0, nullptr, scr, r, lane); continue; } r -= I0;
            if (r < I1) { transpose_item<2>(P.wup, P.wgate, 1024, 5632, WUG0, P.nffn, scr, r, lane); continue; } r -= I1;
            if (r < I2) { transpose_item<0>(P.wdown, nullptr, DFF, 1024, WDN0, nullptr, scr, r, lane); continue; } r -= I2;
            if (r < I3) { transpose_item<0>(P.win1, nullptr, 1024, 3072, WIN1, P.nmix + DM, scr, r, lane); continue; } r -= I3;
            if (r < I4) { transpose_item<0>(P.wout1, nullptr, 1024, 1024, WOUT1, nullptr, scr, r, lane); continue; } r -= I4;
            if (r < I1) { transpose_item<2>(P.wup + (size_t)DM * DFF, P.wgate + (size_t)DM * DFF, 1024, 5632, WUG1, P.nffn + DM, scr, r, lane); continue; } r -= I1;
            transpose_item<0>(P.wdown + (size_t)DFF * DM, nullptr, DFF, 1024, WDN1, nullptr, scr, r, lane); }
        __syncthreads();
        for (int p = vcu; p < 256; p += G)
#pragma unroll 1
            for (int k = 0; k < 3; ++k) { if (k == 2 && p >= 8) break; const int u = k == 1 ? 511 - p : p; const int qb = k == 2 ? -1 : 15 - (u >> 5), bh = u & 31;
                att::attn_unit<0>(lds, CAT, 1536, AK, AV, 512, CAT, 1536, k == 2 ? p : (bh & 7), k == 2 ? 0 : (bh >> 3), qb, BM, P.relb); }
    }
    SEAM(4);
    if (IN(5)) {
        pg8::Gemm g{CAT, WOUT0, 1536}; pg8::SchedPlain S; S.init(NMT, 4, G, bx, 0);
        EpiResid<true> E{P, H, HB, SSQ};
        pg8::gemm_phase(lds, g, S, E);
    }
    SEAM(5);
    if (IN(6)) {
        pg8::Gemm g{HB, WUG0, 1024}; pg8::SchedFfn S; S.init(G, bx);
        EpiFfn E{ACT, SSQ, P.convw, P.convb, (LAS float*)(lds + LDSX_OFF), (LAS float*)(lds + LDSX_OFF + 4096)};
        pg8::gemm_phase(lds, g, S, E);
    }
    SEAM(6);
    if (IN(7)) {
        pg8::Gemm g{ACT, WDN0, DFF}; pg8::SchedPlain S; S.init(NMT, 4, G, bx, 0);
        EpiResid<false> E{P, H, HB, SSQ};
        pg8::gemm_phase(lds, g, S, E);
    }
    SEAM(7);
    if (IN(8)) {
        pg8::Gemm g{HB, WIN1, 1024}; pg8::SchedPlain S; S.init(NMT, 12, G, bx, 0);
        EpiQKV1 E{Q1, K1, V1, SSQ, (LAS float*)(lds + LDSX_OFF + 4096)};
        pg8::gemm_phase(lds, g, S, E);
    }
    SEAM(8);
    if (IN(9)) {
        for (int u = vcu; u < 1040; u += G) { const int bh = u & 63; const int uh = u < 1024 ? (bh & 15) : u - 1024, ub = u < 1024 ? (bh >> 4) : 0, uq = u < 1024 ? 15 - (u >> 6) : -1;
            att::attn_unit<1>(lds, Q1, 1024, K1, V1, 1024, Q1, 1024, uh, ub, uq, nullptr, nullptr); }
    }
    SEAM(9);
    if (IN(10)) {
        pg8::Gemm g{Q1, WOUT1, 1024}; pg8::SchedPlain S; S.init(NMT, 4, G, bx, 0);
        EpiResid<false> E{P, H, HB, SSQ};
        pg8::gemm_phase(lds, g, S, E);
    }
    SEAM(10);
    if (IN(11)) {
        pg8::Gemm g{HB, WUG1, 1024}; pg8::SchedFfn S; S.init(G, bx);
        EpiFfn E{ACT, SSQ, P.convw + 3 * DFF, P.convb + DFF, (LAS float*)(lds + LDSX_OFF), (LAS float*)(lds + LDSX_OFF + 4096)};
        pg8::gemm_phase(lds, g, S, E);
    }
    SEAM(11);
    if (IN(12)) {
        pg8::Gemm g{ACT, WDN1, DFF}; pg8::SchedPlain S; S.init(NMT, 4, G, bx, 0);
        EpiResid<false> E{P, H, HB, SSQ};
        pg8::gemm_phase(lds, g, S, E);
    }
    SEAM(12);
    if (IN(13)) {
        for (int r = ROW0 + gw; r < RT; r += NGW) { const float rn = row_rnorm(SSQ, r); const f32x4* hp = (const f32x4*)(H + (size_t)r * DM); f32x4* op = (f32x4*)(P.out + (size_t)(r - ROW0) * DM);
#pragma unroll
            for (int j = 0; j < 4; ++j) { const f32x4 gnv = ((const f32x4*)P.nfin)[lane + 64 * j]; op[lane + 64 * j] = hp[lane + 64 * j] * rn * gnv; } }
    }
#undef IN
#undef SEAM
}

extern "C" void kernel_launch(void* const* d_in, const int* in_sizes, int n_in, void* d_out, int out_size, void* d_ws, size_t ws_size, hipStream_t stream) {
    static int grid = 0;
    if (grid == 0) {
        if (n_in != 16 || in_sizes[0] != NB * SEQ * DM || out_size != NB * SEQ * DM || ws_size < WS_END) { fprintf(stderr, "kernel_launch: unexpected shapes (n_in %d, in0 %d, out %d, ws %zu); nothing launched\n", n_in, n_in > 0 ? in_sizes[0] : -1, out_size, ws_size); grid = -1; return; }
        int dev = 0, cus = 0, per_cu = 0;
        if (hipGetDevice(&dev) != hipSuccess || hipDeviceGetAttribute(&cus, hipDeviceAttributeMultiprocessorCount, dev) != hipSuccess) { fprintf(stderr, "kernel_launch: device query failed\n"); grid = -1; return; }
        if (hipFuncSetAttribute((const void*)fwd_kernel, hipFuncAttributeMaxDynamicSharedMemorySize, LDS_BYTES) != hipSuccess) { fprintf(stderr, "kernel_launch: hipFuncSetAttribute failed\n"); grid = -1; return; }
        if (hipOccupancyMaxActiveBlocksPerMultiprocessor(&per_cu, (const void*)fwd_kernel, NWAVES * 64, LDS_BYTES) != hipSuccess || per_cu < 1) fprintf(stderr, "kernel_launch: note: occupancy query reports %d workgroups per CU\n", per_cu);
        (void)hipGetLastError();
        grid = cus;
    }
    if (grid < 0) return;
    if (hipMemsetAsync((char*)d_ws + WS_CTL, 0, CTL_ZERO_BYTES, stream) != hipSuccess) { fprintf(stderr, "kernel_launch: hipMemsetAsync failed\n"); return; }
    Params p{};
    p.x = (const float*)d_in[0]; p.meta = (const float*)d_in[1]; p.relb = (const float*)d_in[2]; p.nmix = (const float*)d_in[3]; p.nffn = (const float*)d_in[4]; p.nfin = (const float*)d_in[5];
    p.win0 = (const float*)d_in[6]; p.gng = (const float*)d_in[7]; p.wout0 = (const float*)d_in[8]; p.win1 = (const float*)d_in[9]; p.wout1 = (const float*)d_in[10];
    p.wup = (const float*)d_in[11]; p.wgate = (const float*)d_in[12]; p.convw = (const float*)d_in[13]; p.convb = (const float*)d_in[14]; p.wdown = (const float*)d_in[15];
    p.out = (float*)d_out; p.ws = (unsigned char*)d_ws; p.ph_lo = PH_LO; p.ph_hi = PH_HI;
    hipLaunchKernelGGL(fwd_kernel, dim3(grid), dim3(NWAVES * 64), LDS_BYTES, stream, p);
    const hipError_t le = hipPeekAtLastError();
    if (le != hipSuccess) fprintf(stderr, "kernel_launch: launch failed: %s\n", hipGetErrorName(le));
}
```

```cpp
#include <hip/hip_runtime.h>
#include <hip/hip_bf16.h>
#include <cstdio>
#include <cstdint>
#include <cmath>

#define LAS __attribute__((address_space(3)))
#define GAS __attribute__((address_space(1)))
typedef unsigned short bf16_t;
typedef short bf16x8 __attribute__((ext_vector_type(8)));
typedef short s16x4 __attribute__((ext_vector_type(4)));
typedef float f32x4 __attribute__((ext_vector_type(4)));
typedef float f32x2 __attribute__((ext_vector_type(2)));
typedef float f32x16 __attribute__((ext_vector_type(16)));
typedef unsigned u32x4 __attribute__((ext_vector_type(4)));
typedef unsigned u32x2 __attribute__((ext_vector_type(2)));
typedef __bf16 bf16x2_t __attribute__((ext_vector_type(2)));
#define DI __device__ __forceinline__

constexpr int DM = 1024, NB = 4, SEQ = 4096, NMETA = 16, DFF = 2816;
constexpr int ROW0 = 256;
constexpr int MROW = 240;
constexpr int RT = ROW0 + NB * SEQ;
constexpr int NMT = RT / 256;
constexpr float EPS = 1e-6f;
constexpr float LOG2E = 1.4426950408889634f;
constexpr float LN2 = 0.6931471805599453f;
constexpr float C2 = 0.125f * LOG2E;
constexpr int N0 = 5376;
constexpr int NWAVES = 8;

DI unsigned cvt_pk_bf16(float lo, float hi) { f32x2 v = {lo, hi}; bf16x2_t b = __builtin_convertvector(v, bf16x2_t); return __builtin_bit_cast(unsigned, b); }
DI float bf2f(unsigned short u) { return __uint_as_float((unsigned)u << 16); }
DI float wave_sum(float v) {
#pragma unroll
    for (int o = 1; o < 64; o <<= 1) v += __shfl_xor(v, o);
    return v;
}
DI int opaque_tid() { int t = threadIdx.x; asm volatile("" : "+v"(t)); return t; }
#define LDS_WAIT() asm volatile("s_waitcnt lgkmcnt(0)" ::: "memory")
#define VM_WAIT() asm volatile("s_waitcnt vmcnt(0)" ::: "memory")

namespace pg8 {
constexpr int BM = 256, BK = 64, HALF = 128, HTB = HALF * BK * 2, STAGE_BYTES = 8 * HTB, NXCD = 8, WGM = 8;
__host__ __device__ __forceinline__ int lds_byte(int r, int c) { const int st = (r >> 4) * 2 + (c >> 5), rr = r & 15, cc = c & 31, ob = rr * 64 + cc * 2; return st * 1024 + (ob ^ (((ob >> 9) & 1) << 5)); }
__host__ __device__ __forceinline__ void stage_rc(int b, int& R, int& C) { const int st = b / 1024, sb = b % 1024, swz = sb ^ (((sb >> 9) & 1) << 5); R = (st >> 1) * 16 + swz / 64; C = (st & 1) * 32 + (swz % 64) / 2; }
__host__ __device__ __forceinline__ int perm32(int rho) { const int n = rho >> 4, i = rho & 15; return 8 * (i >> 2) + 4 * n + (i & 3); }

struct Unit { int pm, pn, arow, hrow; };
struct Gemm { const bf16_t* A; const bf16_t* Bt; int K; };

struct Order {
    int nM, nN, nwg, G, c;
    DI void init(int nM_, int nN_, int G_, int c_) { nM = nM_; nN = nN_; nwg = nM * nN; G = G_; c = c_; }
    DI bool tile(int i, int& pm, int& pn) const {
        const long L = (long)i * G + c; if (L >= nwg) return false;
        int wgid = (int)L; { const int q = nwg / NXCD, r = nwg % NXCD, xcd = wgid % NXCD, off = wgid / NXCD; wgid = (xcd < r ? xcd * (q + 1) : r * (q + 1) + (xcd - r) * q) + off; }
        const int nig = WGM * nN, gid = wgid / nig, fm = gid * WGM, gsz = (nM - fm) < WGM ? (nM - fm) : WGM;
        pm = fm + ((wgid % nig) % gsz); pn = (wgid % nig) / gsz; return true;
    }
};
struct SchedPlain {
    static constexpr bool HALO = false;
    Order o; int pm0;
    DI void init(int nM, int nN, int G, int c, int pm0_) { o.init(nM, nN, G, c); pm0 = pm0_; }
    DI bool next(int i, Unit& u) const { int pm, pn; if (!o.tile(i, pm, pn)) return false; u.pm = pm + pm0; u.pn = pn; u.arow = (pm + pm0) * 256; u.hrow = u.arow; return true; }
};
struct SchedFfn {
    static constexpr bool HALO = true;
    Order o;
    DI void init(int G, int c) { o.init(1 + 17 * NB, 22, G, c); }
    DI bool next(int i, Unit& u) const { int pm, pn; if (!o.tile(i, pm, pn)) return false; u.pm = pm; u.pn = pn;
        if (pm == 0) { u.arow = 0; u.hrow = 0; } else { const int b = (pm - 1) / 17, ii = (pm - 1) % 17; u.arow = ROW0 + SEQ * b + 254 * ii - 2; u.hrow = (ii == 0 && b > 0) ? (ROW0 - 2) : u.arow; }
        return true; }
};

template <class Epi, class Sched>
__device__ __forceinline__ void gemm_phase(LAS unsigned char* lds, const Gemm g, const Sched& S, const Epi& E) {
    const int tid = opaque_tid(), wid = __builtin_amdgcn_readfirstlane(tid >> 6), lane = tid & 63, wr = wid >> 2, wc = wid & 3, fr = lane & 15, fq = lane >> 4;
    const int K = g.K, nt = K / BK;
    unsigned voffA[2], voffB[2]; bool hsel[2];
#pragma unroll
    for (int i = 0; i < 2; ++i) { int R, C; stage_rc(tid * 16 + i * 8192, R, C); const int Rb = (R & ~31) + perm32(R & 31);
        voffA[i] = (unsigned)(R * K + C) * 2u; voffB[i] = (unsigned)(Rb * K + C) * 2u; hsel[i] = (R < 2); }
    const size_t kstep = (size_t)(BK * 2);
    const size_t hstep = (size_t)HALF * K * 2;
    const size_t tstep = 2 * hstep;
    const size_t rstep = (size_t)K * 2;
    const unsigned ldsw = (unsigned)wid * 1024u;
    const int aoff = lds_byte(wr * 64 + fr, fq * 8), boff = lds_byte(wc * 32 + fr, fq * 8);
#define PG8_SA(b, h) (((b) * 2 + (h)) * HTB)
#define PG8_SB(b, h) ((4 + (b) * 2 + (h)) * HTB)
#define PG8_STAGE(bufoff, gbase, voff) do { _Pragma("unroll") for (int _i = 0; _i < 2; ++_i) \
        __builtin_amdgcn_global_load_lds((const unsigned*)((const char*)(gbase) + (voff)[_i]), (LAS unsigned*)(lds + (bufoff) + ldsw + _i * 8192), 16, 0, 0); } while (0)
#define PG8_STAGE_A0(bufoff, gbase, dl) do { if constexpr (Sched::HALO) { _Pragma("unroll") for (int _i = 0; _i < 2; ++_i) \
        __builtin_amdgcn_global_load_lds((const unsigned*)((const char*)(gbase) + voffA[_i] + (hsel[_i] ? (dl) : (long)0)), (LAS unsigned*)(lds + (bufoff) + ldsw + _i * 8192), 16, 0, 0); } \
        else { PG8_STAGE(bufoff, gbase, voffA); } } while (0)
#define PG8_LDA(dst, b, h) do { _Pragma("unroll") for (int m = 0; m < 4; ++m) _Pragma("unroll") for (int k = 0; k < 2; ++k) dst[m][k] = *(const LAS bf16x8*)(lds + PG8_SA(b, h) + aoff + m * 2048 + k * 1024); } while (0)
#define PG8_LDB(dst, b, h) do { _Pragma("unroll") for (int n = 0; n < 2; ++n) _Pragma("unroll") for (int k = 0; k < 2; ++k) dst[n][k] = *(const LAS bf16x8*)(lds + PG8_SB(b, h) + boff + n * 2048 + k * 1024); } while (0)
#define PG8_MMA(ai, bj, At, Bt) do { __builtin_amdgcn_s_setprio(1); _Pragma("unroll") for (int m = 0; m < 4; ++m) _Pragma("unroll") for (int n = 0; n < 2; ++n) _Pragma("unroll") for (int k = 0; k < 2; ++k) \
        acc[ai][bj][m][n] = __builtin_amdgcn_mfma_f32_16x16x32_bf16(Bt[n][k], At[m][k], acc[ai][bj][m][n], 0, 0, 0); __builtin_amdgcn_s_setprio(0); } while (0)
#define PG8_WAIT_V(n) asm volatile("s_waitcnt vmcnt(" #n ")" ::: "memory")
#define PG8_WAIT_L(n) asm volatile("s_waitcnt lgkmcnt(" #n ")" ::: "memory")
#define PG8_BAR __builtin_amdgcn_s_barrier()
#define PG8_SCHED __builtin_amdgcn_sched_barrier(0)
    Unit cur, nxt; int ui = 0;
    if (!S.next(0, cur)) return;
    f32x4 acc[2][2][4][2];
#pragma unroll
    for (int a = 0; a < 2; ++a)
#pragma unroll
        for (int b = 0; b < 2; ++b)
#pragma unroll
            for (int m = 0; m < 4; ++m)
#pragma unroll
                for (int n = 0; n < 2; ++n) acc[a][b][m][n] = (f32x4){0.f, 0.f, 0.f, 0.f};
    bf16x8 At[4][2], B0[2][2], B1[2][2];
    const char* cA = (const char*)g.A + (size_t)cur.arow * rstep; const char* cB = (const char*)g.Bt + (size_t)cur.pn * tstep;
    long dc = (long)(cur.hrow - cur.arow) * (long)rstep;
    PG8_STAGE(PG8_SB(0, 0), cB, voffB); PG8_STAGE(PG8_SB(0, 1), cB + hstep, voffB); PG8_STAGE_A0(PG8_SA(0, 0), cA, dc); PG8_STAGE(PG8_SA(0, 1), cA + hstep, voffA);
    if (wr == 1) PG8_BAR;
    PG8_WAIT_V(2); PG8_BAR;
    PG8_STAGE(PG8_SB(1, 0), cB + kstep, voffB); PG8_STAGE_A0(PG8_SA(1, 0), cA + kstep, dc); PG8_STAGE(PG8_SB(1, 1), cB + hstep + kstep, voffB);
    PG8_WAIT_V(6); PG8_BAR;
    for (;;) {
        const bool has_next = S.next(ui + 1, nxt);
        const char* nA = has_next ? (const char*)g.A + (size_t)nxt.arow * rstep : cA; const char* nB = has_next ? (const char*)g.Bt + (size_t)nxt.pn * tstep : cB;
        const long dn = has_next ? (long)(nxt.hrow - nxt.arow) * (long)rstep : dc;
        for (int t = 0; t < nt; t += 2) {
            const bool last = (t == nt - 2);
            const char* a1 = cA + (size_t)(t + 1) * kstep;
            const char* a2 = last ? nA : cA + (size_t)(t + 2) * kstep; const char* b2 = last ? nB : cB + (size_t)(t + 2) * kstep;
            const char* a3 = a2 + kstep; const char* b3 = b2 + kstep;
            const long d2 = last ? dn : dc;
            PG8_LDB(B0, 0, 0); PG8_LDB(B1, 0, 1); PG8_SCHED; PG8_LDA(At, 0, 0); PG8_STAGE(PG8_SA(1, 1), a1 + hstep, voffA);
            PG8_WAIT_V(8); PG8_WAIT_L(0); PG8_BAR; PG8_MMA(0, 0, At, B0); PG8_MMA(0, 1, At, B1); PG8_BAR; PG8_SCHED;
            PG8_LDA(At, 0, 1); PG8_STAGE(PG8_SB(0, 0), b2, voffB); PG8_STAGE(PG8_SB(0, 1), b2 + hstep, voffB); PG8_STAGE_A0(PG8_SA(0, 0), a2, d2);
            PG8_WAIT_V(8); PG8_WAIT_L(0); PG8_BAR; PG8_MMA(1, 0, At, B0); PG8_MMA(1, 1, At, B1); PG8_BAR; PG8_SCHED;
            PG8_LDB(B0, 1, 0); PG8_LDB(B1, 1, 1); PG8_SCHED; PG8_LDA(At, 1, 0); PG8_STAGE(PG8_SA(0, 1), a2 + hstep, voffA);
            PG8_WAIT_V(8); PG8_WAIT_L(0); PG8_BAR; PG8_MMA(0, 0, At, B0); PG8_MMA(0, 1, At, B1); PG8_BAR; PG8_SCHED;
            PG8_LDA(At, 1, 1); PG8_STAGE(PG8_SB(1, 0), b3, voffB); PG8_STAGE(PG8_SB(1, 1), b3 + hstep, voffB); PG8_STAGE_A0(PG8_SA(1, 0), a3, d2);
            PG8_WAIT_V(8); PG8_WAIT_L(0); PG8_BAR; PG8_MMA(1, 0, At, B0); PG8_MMA(1, 1, At, B1); PG8_BAR; PG8_SCHED;
        }
        if (wr == 0) PG8_BAR;
        E(acc, cur, wr, wc, fr, fq, wid, lane);
        if (!has_next) break;
#pragma unroll
        for (int a = 0; a < 2; ++a)
#pragma unroll
            for (int b = 0; b < 2; ++b)
#pragma unroll
                for (int m = 0; m < 4; ++m)
#pragma unroll
                    for (int n = 0; n < 2; ++n) acc[a][b][m][n] = (f32x4){0.f, 0.f, 0.f, 0.f};
        cur = nxt; cA = nA; cB = nB; dc = dn; ++ui;
        if (wr == 1) PG8_BAR;
    }
    PG8_WAIT_V(0);
    PG8_BAR;
#undef PG8_SA
#undef PG8_SB
#undef PG8_STAGE
#undef PG8_STAGE_A0
#undef PG8_LDA
#undef PG8_LDB
#undef PG8_MMA
#undef PG8_WAIT_V
#undef PG8_WAIT_L
#undef PG8_BAR
#undef PG8_SCHED
}
}
constexpr size_t MiB = 1u << 20;
constexpr size_t WS_CTL = 0, CTL_ZERO_BYTES = 64 * 1024;
constexpr size_t WS_SSQ = 1 * MiB;
constexpr size_t WS_AK = 3 * MiB, WS_AV = 20 * MiB, WS_IQ = 37 * MiB;
constexpr size_t WS_H = 3 * MiB;
constexpr size_t WS_SC = 54 * MiB;
constexpr size_t WS_HB = 69 * MiB;
constexpr size_t WS_CAT = 122 * MiB;
constexpr size_t WS_BQ = 171 * MiB, WS_BKZ = 188 * MiB;
constexpr size_t WS_BV = 205 * MiB;
constexpr size_t WS_BIG = 104 * MiB;
constexpr size_t WS_Q1 = 104 * MiB, WS_K1 = 137 * MiB, WS_V1 = 170 * MiB;
constexpr size_t WS_AQ = 238 * MiB;
constexpr size_t WS_O1 = 204 * MiB;
constexpr size_t WS_END = 256 * MiB;
static_assert(WS_AQ + (size_t)RT * 1024 <= WS_END && WS_O1 + (size_t)RT * 2048 <= WS_AQ, "ws map 5");
static_assert(WS_SSQ + (size_t)RT * 64 <= WS_AK && WS_IQ + (size_t)RT * 1024 <= WS_SC && WS_H + (size_t)RT * 4096 <= WS_HB, "ws map 1");
static_assert(WS_SC + 71303168 <= WS_CAT && WS_HB + (size_t)(RT + 1024) * 2048 <= WS_BIG && WS_CAT + (size_t)RT * 3072 <= WS_BQ, "ws map 2");
static_assert(WS_BQ + (size_t)RT * 1024 <= WS_BKZ && WS_BKZ + (size_t)RT * 1024 <= WS_BV && WS_BV + (size_t)RT * 2048 <= WS_END, "ws map 3");
static_assert(WS_BIG + (size_t)RT * DFF * 2 <= WS_END && WS_Q1 + (size_t)RT * 2048 <= WS_K1 && WS_K1 + (size_t)RT * 2048 <= WS_V1 && WS_V1 + (size_t)RT * 2048 <= WS_END, "ws map 4");
constexpr size_t DO_WIN0 = 0;
constexpr size_t DO_RS = 0;
constexpr size_t DO_WOUT0 = 0, DO_WUG0 = 3 * MiB, DO_WDN0 = 14 * MiB, DO_WIN1 = 20 * MiB, DO_WOUT1 = 26 * MiB;
constexpr size_t DO_BM = 32 * MiB;
constexpr size_t DO_ROT = 40 * MiB;
constexpr size_t DO_IK = 43 * MiB;
constexpr size_t DO_IW = 46 * MiB;
constexpr size_t DO_WUG1 = 47 * MiB, DO_WDN1 = 58 * MiB;
static_assert(DO_WDN1 + (size_t)1024 * DFF * 2 <= 64 * MiB && DO_WOUT1 + 2 * MiB <= DO_BM && DO_ROT + 4112 * 64 * 8 <= DO_IK && DO_IK + (size_t)RT * 128 <= DO_IW && DO_IW + (size_t)RT * 32 <= DO_WUG1, "d_out map");
constexpr int CW_TMO = 0, CW_BAR = 1024;
constexpr size_t SC_BATCH = 8912896;

constexpr int RING_BYTES = 131072;
constexpr int LDSX_OFF = RING_BYTES;
constexpr int LDSCTL_OFF = RING_BYTES + 8192, MISC_OFF = LDSCTL_OFF + 320;
constexpr int LDS_BYTES = 147456;

typedef GAS unsigned gu32;
#define RLX_AGENT __ATOMIC_RELAXED, __HIP_MEMORY_SCOPE_AGENT

#define XB_TMO      128
#define XB_XCNT(j)  (256  + 64 * (j))
#define XB_XSUB(j)  (1280 + 64 * (j))
#define XB_XGEN(j)  (2304 + 64 * (j))
#define XB_TOP      3328
#define XB_TOPGEN   3392
#define XCD_BAR_WORDS 3456
#define XB_SPIN_CAP (1u << 18)
DI unsigned xb_ld(unsigned* p)              { return __hip_atomic_load(p, __ATOMIC_RELAXED, __HIP_MEMORY_SCOPE_AGENT); }
DI unsigned xb_add(unsigned* p, unsigned v) { return __hip_atomic_fetch_add(p, v, __ATOMIC_RELAXED, __HIP_MEMORY_SCOPE_AGENT); }
DI unsigned xb_xcc_id() { return (unsigned)__builtin_amdgcn_s_getreg((3 << 11) | 20) & 0xFu; }
#define XB_SPIN(cond, bar) do { unsigned _sp = 0; while (cond) { __builtin_amdgcn_s_sleep(1); \
    if ((++_sp & 255u) == 0u) { if (xb_ld(&(bar)[XB_TMO])) break; if (_sp > XB_SPIN_CAP) { atomicAdd(&(bar)[XB_TMO], 1u); break; } } } } while (0)
struct XcdBarrier { unsigned* bar; unsigned x; volatile LAS unsigned* st; };
DI XcdBarrier xcd_barrier_post(unsigned* bar, volatile LAS unsigned* st) {
    XcdBarrier b; b.bar = bar; b.x = xb_xcc_id(); b.st = st;
    if (threadIdx.x == 0) (void)xb_add(&bar[XB_XCNT(b.x)], 1u);
    return b;
}
DI void xcd_barrier_complete(unsigned* bar, unsigned x, unsigned& nloc, unsigned& nx) {
    const unsigned G = gridDim.x * gridDim.y * gridDim.z;
    unsigned sum, cnt, mine, sp = 0u;
    for (;;) {
        sum = 0u; cnt = 0u; mine = 0u;
#pragma unroll
        for (unsigned j = 0; j < 16; ++j) { const unsigned c = xb_ld(&bar[XB_XCNT(j)]); sum += c; cnt += (c > 0u) ? 1u : 0u; mine = (j == x) ? c : mine; }
        if (sum == G) break;
        __builtin_amdgcn_s_sleep(1);
        if ((++sp & 255u) == 0u) { if (xb_ld(&bar[XB_TMO])) break; if (sp > XB_SPIN_CAP) { atomicAdd(&bar[XB_TMO], 1u); break; } }
    }
    nloc = mine > 0u ? mine : 1u; nx = cnt > 0u ? cnt : 1u;
}
DI void xcd_barrier(const XcdBarrier& b) {
    asm volatile("s_waitcnt vmcnt(0)" ::: "memory");
    __syncthreads();
    if (threadIdx.x == 0) {
        unsigned* bar = b.bar;
        __builtin_amdgcn_s_waitcnt(0);
        unsigned nloc = b.st[0], nx = b.st[1];
        if (nloc == 0u) { xcd_barrier_complete(bar, b.x, nloc, nx); b.st[0] = nloc; b.st[1] = nx; }
        const unsigned old = xb_add(&bar[XB_XSUB(b.x)], 1u);
        const unsigned gen = old / nloc;
        if (old + 1u == (gen + 1u) * nloc) {
            __builtin_amdgcn_fence(__ATOMIC_RELEASE, "agent");
            asm volatile("s_waitcnt vmcnt(0)" ::: "memory");
            const unsigned og = xb_add(&bar[XB_TOP], 1u);
            const unsigned tg = og / nx;
            if (og + 1u == (tg + 1u) * nx) xb_add(&bar[XB_TOPGEN], 1u);
            else XB_SPIN(xb_ld(&bar[XB_TOPGEN]) == tg, bar);
            __builtin_amdgcn_fence(__ATOMIC_ACQUIRE, "agent");
            xb_add(&bar[XB_XGEN(b.x)], 1u);
            asm volatile("s_waitcnt vmcnt(0)" ::: "memory");
        } else {
            XB_SPIN(xb_ld(&bar[XB_XGEN(b.x)]) == gen, bar);
            __builtin_amdgcn_fence(__ATOMIC_ACQUIRE, "agent");
            asm volatile("s_waitcnt vmcnt(0)" ::: "memory");
        }
    }
    __syncthreads();
}

struct Params {
    const float* x; const float* meta; const float* relb; const float* nmix; const float* nffn; const float* nfin;
    const float* win0; const float* gng; const float* wout0; const float* win1; const float* wout1;
    const float* wup; const float* wgate; const float* convw; const float* convb; const float* wdown;
    float* out; unsigned char* ws; int ph_lo, ph_hi;
};

DI int g0_src(int n) {
    const int pn = n >> 8, c = n & 255;
    if (pn < 8) return n;
    if (pn == 8) return c < 64 ? 2048 + c : (c < 72 ? 2112 + (c - 64) : -1);
    if (pn < 13) { const int base = pn < 11 ? 2120 : 2632, t = pn < 11 ? pn - 9 : pn - 11, half = c >> 7, cc = c & 127; return base + 128 * (2 * t + (cc >> 6)) + 64 * half + (cc & 63); }
    if (pn < 17) return 3144 + 256 * (pn - 13) + c;
    return 4168 + 256 * (pn - 17) + c;
}
template <int MODE>
DI void transpose_item(const float* W, const float* W2, int K, int N, bf16_t* WT, const float* gain, LAS float* scr, int item, int lane) {
    const int nblk = N / 32, kb = item / nblk, nb = item % nblk, k0 = 64 * kb, n0 = 32 * nb;
    const int n = n0 + (lane & 31);
    const float* src = W; int sc = n, ld = N;
    if (MODE == 1) { sc = g0_src(n); ld = 5192; }
    if (MODE == 2) { const int j = n >> 8, c = n & 255; if (c < 128) { sc = 128 * j + c; } else { src = W2; sc = 128 * j + c - 128; } ld = DFF; }
#pragma unroll 8
    for (int i = 0; i < 32; ++i) { const int kk = 2 * i + (lane >> 5); float v = 0.f; if (sc >= 0) v = src[(size_t)(k0 + kk) * ld + sc]; if (gain) v *= gain[k0 + kk]; scr[kk * 33 + (lane & 31)] = v; }
    LDS_WAIT(); asm volatile("" ::: "memory");
    const int c = lane & 7;
#pragma unroll
    for (int j = 0; j < 4; ++j) { const int nn = (lane >> 3) + 8 * j; const LAS float* s = scr + (8 * c) * 33 + nn;
        u32x4 o; o.x = cvt_pk_bf16(s[0 * 33], s[1 * 33]); o.y = cvt_pk_bf16(s[2 * 33], s[3 * 33]); o.z = cvt_pk_bf16(s[4 * 33], s[5 * 33]); o.w = cvt_pk_bf16(s[6 * 33], s[7 * 33]);
        *(u32x4*)(WT + (size_t)(n0 + nn) * K + k0 + 8 * c) = o; }
    LDS_WAIT(); asm volatile("" ::: "memory");
}
DI const float* h0_row(const Params& P, int r) { return r < MROW ? nullptr : (r < ROW0 ? P.meta + (size_t)(r - MROW) * DM : P.x + (size_t)(r - ROW0) * DM); }
DI float row_rnorm(const float* ssq, int r) {
    const f32x4* p = (const f32x4*)(ssq + (size_t)r * 16); const f32x4 a = p[0], b = p[1], c = p[2], d = p[3];
    const float s = ((a.x + a.y) + (a.z + a.w)) + ((b.x + b.y) + (b.z + b.w)) + ((c.x + c.y) + (c.z + c.w)) + ((d.x + d.y) + (d.z + d.w));
    return 1.0f / sqrtf(s * (1.0f / DM) + EPS);
}
#define EPI_ARGS const f32x4 (&acc)[2][2][4][2], const pg8::Unit& u, int wr, int wc, int fr, int fq, int wid, int lane
DI float gamma_log2(int h) { return log2f(1.0f - exp2f(-5.0f - (float)h)); }
DI void unit_rnorm(LAS float* RN, const float* ssq, int arow) {
    const int t = threadIdx.x;
    if (t < 256) { int row = arow + t; row = row < RT ? row : RT - 1; RN[t] = row_rnorm(ssq, row); }
    asm volatile("s_waitcnt lgkmcnt(0)" ::: "memory"); __builtin_amdgcn_s_barrier(); asm volatile("" ::: "memory");
}

struct EpiG0 {
    bf16_t *CAT, *AQ, *AK, *AV, *IQ, *IK, *BQ, *BKZ, *BV; float* IW; const float* ssq; const f32x2* rot; LAS float* RN;
    DI void operator()(EPI_ARGS) const {
        const int pn = u.pn;
        unit_rnorm(RN, ssq, u.arow);
        float rs[2][4];
#pragma unroll
        for (int ai = 0; ai < 2; ++ai)
#pragma unroll
            for (int m = 0; m < 4; ++m) rs[ai][m] = RN[128 * ai + 64 * wr + 16 * m + fr];
        if (pn < 8 || pn >= 13) {
            bf16_t* base; int pitch, col0; float sc = 1.f;
            if (pn < 2) { base = AQ; pitch = 512; col0 = 256 * pn; sc = C2; }
            else if (pn < 4) { base = AK; pitch = 512; col0 = 256 * (pn - 2); }
            else if (pn < 6) { base = AV; pitch = 512; col0 = 256 * (pn - 4); }
            else if (pn < 8) { base = IQ; pitch = 512; col0 = 256 * (pn - 6); sc = 0.125f; }
            else if (pn < 17) { base = BV; pitch = 1024; col0 = 256 * (pn - 13); }
            else { base = CAT; pitch = 1536; col0 = 512 + 256 * (pn - 17); }
            col0 += 32 * wc + 8 * fq;
#pragma unroll
            for (int ai = 0; ai < 2; ++ai)
#pragma unroll
                for (int m = 0; m < 4; ++m) { const int row = u.arow + 128 * ai + 64 * wr + 16 * m + fr; const float s = rs[ai][m] * sc; bf16_t* rp = base + (size_t)row * pitch + col0;
#pragma unroll
                    for (int bj = 0; bj < 2; ++bj) { const f32x4 v0 = acc[ai][bj][m][0] * s, v1 = acc[ai][bj][m][1] * s;
                        u32x4 w; w.x = cvt_pk_bf16(v0[0], v0[1]); w.y = cvt_pk_bf16(v0[2], v0[3]); w.z = cvt_pk_bf16(v1[0], v1[1]); w.w = cvt_pk_bf16(v1[2], v1[3]);
                        *(u32x4*)(rp + bj * 128) = w; } }
        } else if (pn == 8) {
#pragma unroll
            for (int ai = 0; ai < 2; ++ai)
#pragma unroll
                for (int m = 0; m < 4; ++m) { const int row = u.arow + 128 * ai + 64 * wr + 16 * m + fr; const float s = rs[ai][m];
                    if (wc < 2) { const f32x4 v0 = acc[ai][0][m][0] * s, v1 = acc[ai][0][m][1] * s;
                        u32x4 w; w.x = cvt_pk_bf16(v0[0], v0[1]); w.y = cvt_pk_bf16(v0[2], v0[3]); w.z = cvt_pk_bf16(v1[0], v1[1]); w.w = cvt_pk_bf16(v1[2], v1[3]);
                        *(u32x4*)(IK + (size_t)row * 64 + 32 * wc + 8 * fq) = w; }
                    else if (wc == 2 && fq == 0) { const float s2 = s * 0.35355339059327373f; *(f32x4*)(IW + (size_t)row * 8) = acc[ai][0][m][0] * s2; *(f32x4*)(IW + (size_t)row * 8 + 4) = acc[ai][0][m][1] * s2; } }
        } else {
            const bool isk = pn >= 11; const int t = isk ? pn - 11 : pn - 9, head = 2 * t + (wc >> 1), i0 = 32 * (wc & 1) + 8 * fq;
            bf16_t* base = isk ? BKZ : BQ; const float lg = gamma_log2(head);
#pragma unroll
            for (int ai = 0; ai < 2; ++ai)
#pragma unroll
                for (int m = 0; m < 4; ++m) { const int row = u.arow + 128 * ai + 64 * wr + 16 * m + fr;
                    int pos = row < ROW0 ? row - MROW : 16 + ((row - ROW0) & (SEQ - 1)); pos = pos < 0 ? 0 : pos;
                    float s = rs[ai][m]; if (isk) s *= 0.08838834764831845f * exp2f((float)(127 - (row & 127)) * lg);
                    const f32x4* rp = (const f32x4*)(rot + (size_t)pos * 64 + i0); const f32x4 r0 = rp[0], r1 = rp[1], r2 = rp[2], r3 = rp[3];
                    const float cs[8] = {r0[0], r0[2], r1[0], r1[2], r2[0], r2[2], r3[0], r3[2]}, sn[8] = {r0[1], r0[3], r1[1], r1[3], r2[1], r2[3], r3[1], r3[3]};
                    float o1[8], o2[8];
#pragma unroll
                    for (int n = 0; n < 2; ++n)
#pragma unroll
                        for (int j = 0; j < 4; ++j) { const float x1 = acc[ai][0][m][n][j] * s, x2 = acc[ai][1][m][n][j] * s; o1[4 * n + j] = x1 * cs[4 * n + j] - x2 * sn[4 * n + j]; o2[4 * n + j] = x2 * cs[4 * n + j] + x1 * sn[4 * n + j]; }
                    u32x4 w1, w2; w1.x = cvt_pk_bf16(o1[0], o1[1]); w1.y = cvt_pk_bf16(o1[2], o1[3]); w1.z = cvt_pk_bf16(o1[4], o1[5]); w1.w = cvt_pk_bf16(o1[6], o1[7]);
                    w2.x = cvt_pk_bf16(o2[0], o2[1]); w2.y = cvt_pk_bf16(o2[2], o2[3]); w2.z = cvt_pk_bf16(o2[4], o2[5]); w2.w = cvt_pk_bf16(o2[6], o2[7]);
                    bf16_t* op = base + (size_t)row * 512 + 128 * head + i0; *(u32x4*)op = w1; *(u32x4*)(op + 64) = w2; }
        }
    }
};

template <bool FIRST>
struct EpiResid {
    Params P; bf16_t* HB; float* ssq;
    DI void operator()(EPI_ARGS) const {
        const int colb = 256 * u.pn + 32 * wc + 8 * fq;
#pragma unroll
        for (int ai = 0; ai < 2; ++ai)
#pragma unroll
            for (int m = 0; m < 4; ++m) { const int row = u.arow + 128 * ai + 64 * wr + 16 * m + fr; float sq = 0.f;
#pragma unroll
                for (int bj = 0; bj < 2; ++bj) { const int col = colb + 128 * bj;
                    f32x4 b0, b1;
                    if (FIRST) { const float* bp = P.x + (size_t)(row - ROW0) * DM + col; b0 = *(const f32x4*)bp; b1 = *(const f32x4*)(bp + 4); }
                    else { const u32x4 hb = *(const u32x4*)(HB + (size_t)row * DM + col);
                        b0 = (f32x4){__uint_as_float(hb.x << 16), __uint_as_float(hb.x & 0xffff0000u), __uint_as_float(hb.y << 16), __uint_as_float(hb.y & 0xffff0000u)};
                        b1 = (f32x4){__uint_as_float(hb.z << 16), __uint_as_float(hb.z & 0xffff0000u), __uint_as_float(hb.w << 16), __uint_as_float(hb.w & 0xffff0000u)}; }
                    const f32x4 v0 = b0 + acc[ai][bj][m][0], v1 = b1 + acc[ai][bj][m][1];
                    u32x4 w; w.x = cvt_pk_bf16(v0[0], v0[1]); w.y = cvt_pk_bf16(v0[2], v0[3]); w.z = cvt_pk_bf16(v1[0], v1[1]); w.w = cvt_pk_bf16(v1[2], v1[3]);
                    *(u32x4*)(HB + (size_t)row * DM + col) = w;
                    sq += (v0[0] * v0[0] + v0[1] * v0[1]) + (v0[2] * v0[2] + v0[3] * v0[3]) + (v1[0] * v1[0] + v1[1] * v1[1]) + (v1[2] * v1[2] + v1[3] * v1[3]); }
                sq += __shfl_xor(sq, 16); sq += __shfl_xor(sq, 32);
                if (fq == 0) ssq[(size_t)row * 16 + 4 * u.pn + wc] = sq; }
    }
};

struct EpiQKV1 {
    bf16_t *Q1, *K1, *V1; const float* ssq; LAS float* RN;
    DI void operator()(EPI_ARGS) const {
        unit_rnorm(RN, ssq, u.arow);
        const int pn = u.pn; bf16_t* base = Q1 + (size_t)(pn >> 2) * ((WS_K1 - WS_Q1) / 2);     const float sc = pn < 4 ? 0.125f : 1.f; const int col0 = 256 * (pn & 3) + 32 * wc + 8 * fq;
#pragma unroll
        for (int ai = 0; ai < 2; ++ai)
#pragma unroll
            for (int m = 0; m < 4; ++m) { const int row = u.arow + 128 * ai + 64 * wr + 16 * m + fr; const float s = RN[128 * ai + 64 * wr + 16 * m + fr] * sc; bf16_t* rp = base + (size_t)row * DM + col0;
#pragma unroll
                for (int bj = 0; bj < 2; ++bj) { const f32x4 v0 = acc[ai][bj][m][0] * s, v1 = acc[ai][bj][m][1] * s;
                    u32x4 w; w.x = cvt_pk_bf16(v0[0], v0[1]); w.y = cvt_pk_bf16(v0[2], v0[3]); w.z = cvt_pk_bf16(v1[0], v1[1]); w.w = cvt_pk_bf16(v1[2], v1[3]);
                    *(u32x4*)(rp + bj * 128) = w; } }
    }
};

DI float ror16(float v, int k, int lane) { return __shfl(v, (lane & 48) | ((lane - k) & 15)); }
struct EpiFfn {
    bf16_t* ACT; const float* ssq; const float* cw; const float* cb; LAS float* X; LAS float* RN;
    DI void operator()(EPI_ARGS) const {
        const int cl = 32 * wc + 8 * fq, cg = 128 * u.pn + cl;
        if (fr >= 14) {
#pragma unroll
            for (int ai = 0; ai < 2; ++ai) { LAS float* xp = X + ((ai * 2 + wr) * 2 + (fr - 14)) * 128 + cl;
                *(LAS f32x4*)xp = acc[ai][1][3][0]; *(LAS f32x4*)(xp + 4) = acc[ai][1][3][1]; }
        }
        unit_rnorm(RN, ssq, u.arow);
        float rs[2][4];
#pragma unroll
        for (int ai = 0; ai < 2; ++ai)
#pragma unroll
            for (int m = 0; m < 4; ++m) rs[ai][m] = RN[128 * ai + 64 * wr + 16 * m + fr];
        const int bidx = u.pm == 0 ? 0 : (u.pm - 1) / 17; const int rend = u.pm == 0 ? 256 : ROW0 + SEQ * (bidx + 1);
#pragma unroll
        for (int q = 0; q < 2; ++q) {
            const f32x4 w0 = *(const f32x4*)(cw + cg + 4 * q), w1 = *(const f32x4*)(cw + DFF + cg + 4 * q), w2 = *(const f32x4*)(cw + 2 * DFF + cg + 4 * q), bb = *(const f32x4*)(cb + cg + 4 * q);
#pragma unroll
            for (int ai = 0; ai < 2; ++ai) {
                f32x4 pv = {0.f, 0.f, 0.f, 0.f};
                const int g = ai * 2 + wr;
                if (g > 0 && fr >= 14) pv = *(const LAS f32x4*)(X + ((g - 1) * 2 + (fr - 14)) * 128 + cl + 4 * q) * RN[64 * (g - 1) + 48 + fr];
#pragma unroll
                for (int m = 0; m < 4; ++m) { const int rt = 128 * ai + 64 * wr + 16 * m + fr, row = u.arow + rt; const float s = rs[ai][m]; float o[4];
#pragma unroll
                    for (int j = 0; j < 4; ++j) { const float cur = acc[ai][1][m][q][j] * s; const float c1 = ror16(cur, 1, lane), c2 = ror16(cur, 2, lane), q1 = ror16(pv[j], 1, lane), q2 = ror16(pv[j], 2, lane);
                        const float p1 = fr >= 1 ? c1 : q1, p2 = fr >= 2 ? c2 : q2;
                        const float gc = w0[j] * p2 + w1[j] * p1 + w2[j] * cur + bb[j];
                        const float sg = __builtin_amdgcn_rcpf(1.0f + __builtin_amdgcn_exp2f(-gc * LOG2E));
                        o[j] = gc * sg * (acc[ai][0][m][q][j] * s); pv[j] = cur; }
                    const bool ok = (u.pm == 0 || rt >= 2) && row < rend;
                    if (ok) { u32x2 w; w.x = cvt_pk_bf16(o[0], o[1]); w.y = cvt_pk_bf16(o[2], o[3]); *(u32x2*)(ACT + (size_t)row * DFF + cg + 4 * q) = w; } }
            }
        }
    }
};
template <bool RESID, bool FIRST>
DI void skinny_job(LAS unsigned char* lds, const bf16_t* A, const bf16_t* Bt, int K, int job, const Params& P, float* H, bf16_t* HB, float* SSQ, bf16_t* Q1) {
    const int tid = opaque_tid(), lane = tid & 63, fr = lane & 15, fq = lane >> 4; const int wid = __builtin_amdgcn_readfirstlane(tid >> 6);
    const int t = wid & 3, kh = wid >> 2, kh0 = kh * (K >> 1);
    const bf16_t* ap = A + (size_t)(MROW + fr) * K + kh0 + fq * 8;
    const bf16_t* bp = Bt + (size_t)(64 * job + 16 * t + fr) * K + kh0 + fq * 8;
    f32x4 acc = {0.f, 0.f, 0.f, 0.f};
    const int nks = K >> 6;
#pragma unroll 4
    for (int ks = 0; ks < nks; ++ks) { const bf16x8 a = *(const bf16x8*)(ap + 32 * ks), b = *(const bf16x8*)(bp + 32 * ks); acc = __builtin_amdgcn_mfma_f32_16x16x32_bf16(b, a, acc, 0, 0, 0); }
    LAS f32x4* red = (LAS f32x4*)lds;
    LAS float* sqx = (LAS float*)(lds + 4096);
    if (kh == 1) red[t * 64 + lane] = acc;
    __syncthreads();
    const int row = MROW + fr, col = 64 * job + 16 * t + 4 * fq;
    if (kh == 0) {
        acc += red[t * 64 + lane];
        if (RESID) {
            f32x4 b0 = {0.f, 0.f, 0.f, 0.f};
            if (FIRST) b0 = *(const f32x4*)(P.meta + (size_t)fr * DM + col);
            else { const u32x2 hb = *(const u32x2*)(HB + (size_t)row * DM + col); b0 = (f32x4){__uint_as_float(hb.x << 16), __uint_as_float(hb.x & 0xffff0000u), __uint_as_float(hb.y << 16), __uint_as_float(hb.y & 0xffff0000u)}; }
            const f32x4 v = b0 + acc;
            u32x2 w; w.x = cvt_pk_bf16(v[0], v[1]); w.y = cvt_pk_bf16(v[2], v[3]); *(u32x2*)(HB + (size_t)row * DM + col) = w;
            float sq = (v[0] * v[0] + v[1] * v[1]) + (v[2] * v[2] + v[3] * v[3]);
            sq += __shfl_xor(sq, 16); sq += __shfl_xor(sq, 32);
            if (fq == 0) sqx[t * 16 + fr] = sq;
        } else {
            const float s = row_rnorm(SSQ, row) * (job < 16 ? 0.125f : 1.f);
            bf16_t* base = Q1 + (size_t)(job >> 4) * ((WS_K1 - WS_Q1) / 2);
            const f32x4 v = acc * s; u32x2 w; w.x = cvt_pk_bf16(v[0], v[1]); w.y = cvt_pk_bf16(v[2], v[3]);
            *(u32x2*)(base + (size_t)row * DM + (col & 1023)) = w;
        }
    }
    __syncthreads();
    if (RESID && tid < 16) SSQ[(size_t)(MROW + tid) * 16 + job] = (sqx[tid] + sqx[16 + tid]) + (sqx[32 + tid] + sqx[48 + tid]);
    __syncthreads();
}
namespace att {
constexpr int A_K = 0, A_V = 16384, A_WS = 32768, A_OST = 34816, A_TB = 67584, A_FLG = 68096;
DI int crow(int r, int hi) { return (r & 3) + 8 * (r >> 2) + 4 * hi; }
#define SBAR() __builtin_amdgcn_sched_barrier(0)
#define MFMA32(a, b, c) __builtin_amdgcn_mfma_f32_32x32x16_bf16((a), (b), (c), 0, 0, 0)

DI void pv(f32x16* o, int vb, bf16x8 pa0, bf16x8 pa1, bf16x8 pa2, bf16x8 pa3) {
#pragma unroll
    for (int d0 = 0; d0 < 2; ++d0) { s16x4 lo[4], hi[4];
#pragma unroll
        for (int ks = 0; ks < 4; ++ks) {
            asm volatile("ds_read_b64_tr_b16 %0,%1 offset:%c2" : "=&v"(lo[ks]) : "v"(vb), "i"(d0 * 4096 + ks * 1024) : "memory");
            asm volatile("ds_read_b64_tr_b16 %0,%1 offset:%c2" : "=&v"(hi[ks]) : "v"(vb), "i"(d0 * 4096 + ks * 1024 + 512) : "memory"); }
        asm volatile("s_waitcnt lgkmcnt(0)" ::: "memory"); SBAR();
#define PK(k) (bf16x8){lo[k][0], lo[k][1], lo[k][2], lo[k][3], hi[k][0], hi[k][1], hi[k][2], hi[k][3]}
        o[d0] = MFMA32(pa0, PK(0), o[d0]); o[d0] = MFMA32(pa1, PK(1), o[d0]); o[d0] = MFMA32(pa2, PK(2), o[d0]); o[d0] = MFMA32(pa3, PK(3), o[d0]);
#undef PK
    }
}
DI bf16x8 pack8(const f32x16& p, int b) { u32x4 w; w.x = cvt_pk_bf16(p[b], p[b + 1]); w.y = cvt_pk_bf16(p[b + 2], p[b + 3]); w.z = cvt_pk_bf16(p[b + 4], p[b + 5]); w.w = cvt_pk_bf16(p[b + 6], p[b + 7]); return __builtin_bit_cast(bf16x8, w); }

DI int t5_bucket(int n) {
    if (n < 16) return n;
    int b = 16; const int th[15] = {19, 21, 24, 27, 31, 35, 40, 46, 52, 59, 67, 77, 87, 99, 113};
#pragma unroll
    for (int i = 0; i < 15; ++i) b += (n >= th[i]) ? 1 : 0;
    return b;
}

template <int KIND>
DI void attn_unit(LAS unsigned char* lds, const bf16_t* Q, int qp, const bf16_t* Kg, const bf16_t* Vg, int kvp, bf16_t* O, int op, int h, int b, int qb, const unsigned char* BM, const float* relb) {
    const int tid = opaque_tid(), lane = tid & 63, r32 = lane & 31, hi = lane >> 5; const int wid = __builtin_amdgcn_readfirstlane(tid >> 6);
    const int qrow0 = qb < 0 ? 0 : ROW0 + SEQ * b + 256 * qb;
    const int qrow = qrow0 + 32 * wid + r32;
    const int qposw = qb < 0 ? 32 * wid - MROW : 16 + 256 * qb + 32 * wid;
    const int qpos = qposw + r32;
    bf16x8 qr[4];
#pragma unroll
    for (int d0 = 0; d0 < 4; ++d0) qr[d0] = *(const bf16x8*)(Q + (size_t)qrow * qp + h * 64 + d0 * 16 + hi * 8);
    LAS float* TB = (LAS float*)(lds + A_TB);
    LAS float* wsf = (LAS float*)(lds + A_WS) + wid * 64;
    volatile LAS int* flg = (volatile LAS int*)(lds + A_FLG);
    if (KIND == 0) { if (tid < 128) TB[tid] = relb[t5_bucket(tid) * 8 + h] * LOG2E; }
    else { if (tid < 16) flg[tid] = 0; }
    const int nreal = qb < 0 ? 0 : 4 * (qb + 1);
    const int nt = nreal + 1;
#define TILE_RT(it) (KIND == 0 ? (it) - 1 : ((it) < nreal ? nreal - 1 - (it) : -1))
#define TILE_ROW0(rt) ((rt) < 0 ? 192 : ROW0 + SEQ * b + 64 * (rt))
    const bf16_t* kb_ = Kg + h * 64 + wid * 8 + (size_t)lane * kvp;
    const bf16_t* vb_ = Vg + h * 64 + (wid >> 2) * 32 + (lane & 3) * 8 + (size_t)(16 * (wid & 3) + (lane >> 2)) * kvp;
    u32x4 kreg, vreg;
    { const int row0 = TILE_ROW0(TILE_RT(0)); kreg = *(const u32x4*)(kb_ + (size_t)row0 * kvp); vreg = *(const u32x4*)(vb_ + (size_t)row0 * kvp); }
    float mrun = -INFINITY, lsum = 0.f, carry = 0.f; bool wdone = false;
    f32x16 o[2]; o[0] = f32x16{}; o[1] = f32x16{};
    const unsigned ldsb = (unsigned)(size_t)lds;
    const int vlane = ((lane >> 4) & 1) * 32 + (lane & 3) * 8 + (4 * hi + ((lane & 15) >> 2)) * 64;
    for (int it = 0; it < nt; ++it) {
        const int slot = it & 1;
        *(LAS u32x4*)(lds + A_K + slot * 8192 + wid * 1024 + lane * 16) = kreg;
        *(LAS u32x4*)(lds + A_V + slot * 8192 + wid * 1024 + lane * 16) = vreg;
        __syncthreads();
        if (KIND == 1 && it > 0) { int all = 1;
#pragma unroll
            for (int w = 0; w < 8; ++w) all &= flg[((it - 1) & 1) * 8 + w];
            if (all) break; }
        const int rt = TILE_RT(it);
        if (it + 1 < nt) { const int row0 = TILE_ROW0(TILE_RT(it + 1)); kreg = *(const u32x4*)(kb_ + (size_t)row0 * kvp); vreg = *(const u32x4*)(vb_ + (size_t)row0 * kvp); }
        const int kpos0 = rt < 0 ? -48 : 16 + 64 * rt;
        bool active = true;
        if (KIND == 1) active = !wdone && (kpos0 < qposw + 31);
        unsigned wlo = 0u, whi = 0u;
        if (KIND == 0) {
            if (rt >= 0) { const u32x2 w = *(const u32x2*)(BM + (size_t)(SEQ * b + 256 * qb + 32 * wid + r32) * 512 + 8 * rt); wlo = w.x; whi = w.y; }
            else { const int top = qpos < 15 ? qpos : 15; whi = top < 0 ? 0u : (((2u << top) - 1u) << 16); }
        }
        if (active) {
            f32x16 p0 = f32x16{}, p1 = f32x16{};
            { const LAS unsigned char* kb = lds + A_K + slot * 8192 + hi * 1024 + r32 * 16;
#pragma unroll
              for (int d0 = 0; d0 < 4; ++d0) { const bf16x8 b0 = *(const LAS bf16x8*)(kb + d0 * 2048), b1 = *(const LAS bf16x8*)(kb + d0 * 2048 + 512);
                  p0 = MFMA32(b0, qr[d0], p0); p1 = MFMA32(b1, qr[d0], p1); } }
            if (KIND == 0) {
                if (qposw - (kpos0 + 63) >= 127) { const float c = TB[127];
#pragma unroll
                    for (int r = 0; r < 16; ++r) { p0[r] += c; p1[r] += c; } }
                else {
#pragma unroll
                    for (int r = 0; r < 16; ++r) { int rel = qpos - (kpos0 + crow(r, hi)); int i0 = rel < 0 ? 0 : (rel > 127 ? 127 : rel); rel -= 32; int i1 = rel < 0 ? 0 : (rel > 127 ? 127 : rel);
                        p0[r] += TB[i0]; p1[r] += TB[i1]; } }
                const unsigned ml = wlo >> (4 * hi), mh = whi >> (4 * hi);
#pragma unroll
                for (int r = 0; r < 16; ++r) { const unsigned bit = 1u << ((r & 3) + 8 * (r >> 2)); p0[r] = (ml & bit) ? p0[r] : -INFINITY; p1[r] = (mh & bit) ? p1[r] : -INFINITY; }
                float mx = -INFINITY;
#pragma unroll
                for (int r = 0; r < 16; ++r) mx = fmaxf(mx, fmaxf(p0[r], p1[r]));
                mx = fmaxf(mx, __shfl_xor(mx, 32));
                const float mnew = fmaxf(mrun, mx), msafe = (mnew == -INFINITY) ? 0.f : mnew;
                const float alpha = __builtin_amdgcn_exp2f(mrun - msafe);
                mrun = mnew;
                float ps = 0.f;
#pragma unroll
                for (int r = 0; r < 16; ++r) { p0[r] = __builtin_amdgcn_exp2f(p0[r] - msafe); p1[r] = __builtin_amdgcn_exp2f(p1[r] - msafe); ps += p0[r] + p1[r]; }
                lsum = lsum * alpha + ps;
                if (hi == 0) wsf[r32] = alpha;
                LDS_WAIT(); asm volatile("" ::: "memory");
#pragma unroll
                for (int r = 0; r < 16; ++r) { const float a = wsf[crow(r, hi)]; o[0][r] *= a; o[1][r] *= a; }
            } else {
                float L0[16], L1[16];
#pragma unroll
                for (int r = 0; r < 16; ++r) {
                    const int k0 = kpos0 + crow(r, hi), k1 = k0 + 32;
                    { const float z = p0[r], sp = fmaxf(z, 0.f) + LN2 * __builtin_amdgcn_logf(1.0f + __builtin_amdgcn_exp2f(-fabsf(z) * LOG2E)); const bool v = (k0 < qpos) && (k0 >= 0); L0[r] = v ? -sp : 0.f; p0[r] = v ? z - sp : -INFINITY; }
                    { const float z = p1[r], sp = fmaxf(z, 0.f) + LN2 * __builtin_amdgcn_logf(1.0f + __builtin_amdgcn_exp2f(-fabsf(z) * LOG2E)); const bool v = (k1 < qpos) && (k1 >= 0); L1[r] = v ? -sp : 0.f; p1[r] = v ? z - sp : -INFINITY; }
                }
                float g0[4], g1[4], og0[4], og1[4];
#pragma unroll
                for (int i = 0; i < 4; ++i) { g0[i] = (L0[4 * i] + L0[4 * i + 1]) + (L0[4 * i + 2] + L0[4 * i + 3]); g1[i] = (L1[4 * i] + L1[4 * i + 1]) + (L1[4 * i + 2] + L1[4 * i + 3]); og0[i] = __shfl_xor(g0[i], 32); og1[i] = __shfl_xor(g1[i], 32); }
                float sg1[4], sg0[4]; float run = 0.f;
#pragma unroll
                for (int i = 3; i >= 0; --i) { sg1[i] = run + (hi == 0 ? og1[i] : 0.f); run += g1[i] + og1[i]; }
#pragma unroll
                for (int i = 3; i >= 0; --i) { sg0[i] = run + (hi == 0 ? og0[i] : 0.f); run += g0[i] + og0[i]; }
#pragma unroll
                for (int i = 0; i < 4; ++i) {
                    float e = carry + sg0[i];
#pragma unroll
                    for (int j = 3; j >= 0; --j) { p0[4 * i + j] = __builtin_amdgcn_exp2f((p0[4 * i + j] + e) * LOG2E); e += L0[4 * i + j]; }
                    e = carry + sg1[i];
#pragma unroll
                    for (int j = 3; j >= 0; --j) { p1[4 * i + j] = __builtin_amdgcn_exp2f((p1[4 * i + j] + e) * LOG2E); e += L1[4 * i + j]; }
                }
                carry += run;
                wdone = __all(carry < -104.0f);
            }
            const bf16x8 pa0 = pack8(p0, 0), pa1 = pack8(p0, 8), pa2 = pack8(p1, 0), pa3 = pack8(p1, 8);
            SBAR();
            pv(o, (int)(ldsb + A_V + slot * 8192) + vlane, pa0, pa1, pa2, pa3);
        }
        if (KIND == 1 && lane == 0) flg[(it & 1) * 8 + wid] = wdone ? 1 : 0;
    }
    float rli[16];
    if (KIND == 0) {
        lsum += __shfl_xor(lsum, 32);
        if (hi == 0) wsf[32 + r32] = lsum;
        LDS_WAIT(); asm volatile("" ::: "memory");
#pragma unroll
        for (int r = 0; r < 16; ++r) { const float l = wsf[32 + crow(r, hi)]; rli[r] = l > 0.f ? __builtin_amdgcn_rcpf(l) : 0.f; }
    } else {
#pragma unroll
        for (int r = 0; r < 16; ++r) rli[r] = 1.f;
    }
    { LAS bf16_t* stg = (LAS bf16_t*)(lds + A_OST) + wid * 2048;
#pragma unroll
      for (int r = 0; r < 16; ++r) { const int orow = crow(r, hi);
#pragma unroll
          for (int d0 = 0; d0 < 2; ++d0) stg[orow * 64 + d0 * 32 + r32] = (bf16_t)(cvt_pk_bf16(o[d0][r] * rli[r], 0.f) & 0xffffu); }
      LDS_WAIT(); asm volatile("" ::: "memory");
      bf16_t* Ow = O + (size_t)(qrow0 + 32 * wid) * op + h * 64;
#pragma unroll
      for (int i = 0; i < 4; ++i) { const int row = i * 8 + (lane >> 3), ch = lane & 7; const u32x4 v = *(const LAS u32x4*)(stg + row * 64 + ch * 8); *(u32x4*)(Ow + (size_t)row * op + ch * 8) = v; } }
    __syncthreads();
#undef TILE_RT
#undef TILE_ROW0
}
}
DI size_t sc_row_off(int b, int t) { const int Q = t >> 8; return (size_t)b * SC_BATCH + (size_t)32768 * Q * (Q + 1) + (size_t)(t & 255) * 256 * (Q + 1); }
DI void indexer_item(int item, const bf16_t* IQ, const bf16_t* IK, const float* IW, unsigned short* SC, int lane) {
    const int b = item / 576; int r = item % 576;
    int g = 0; while (r >= 8 * (g + 1) * (g + 2)) ++g;
    r -= 8 * g * (g + 1);
    const int qblk = 16 * g + r / (g + 1), kc = r % (g + 1);
    const int r32 = lane & 31, hi = lane >> 5;
    const int t = 32 * qblk + r32, row = ROW0 + SEQ * b + t;
    bf16x8 qf[8][4]; float w[8];
#pragma unroll
    for (int h = 0; h < 8; ++h) {
#pragma unroll
        for (int s = 0; s < 4; ++s) qf[h][s] = *(const bf16x8*)(IQ + (size_t)row * 512 + h * 64 + s * 16 + hi * 8);
        w[h] = IW[(size_t)row * 8 + h]; }
    unsigned short* scrow = SC + sc_row_off(b, t);
    const int kt1 = (kc * 16 + 15) < qblk ? (kc * 16 + 15) : qblk;
    for (int kt = kc * 16; kt <= kt1; ++kt) {
        const int krow = ROW0 + SEQ * b + 32 * kt + r32;
        bf16x8 kf[4];
#pragma unroll
        for (int s = 0; s < 4; ++s) kf[s] = *(const bf16x8*)(IK + (size_t)krow * 64 + s * 16 + hi * 8);
        f32x16 sc = f32x16{};
#pragma unroll
        for (int h = 0; h < 8; ++h) { f32x16 a = f32x16{};
#pragma unroll
            for (int s = 0; s < 4; ++s) a = __builtin_amdgcn_mfma_f32_32x32x16_bf16(kf[s], qf[h][s], a, 0, 0, 0);
#pragma unroll
            for (int i = 0; i < 16; ++i) sc[i] += fmaxf(a[i], 0.f) * w[h]; }
#pragma unroll
        for (int gq = 0; gq < 4; ++gq) { unsigned v[4];
#pragma unroll
            for (int j = 0; j < 4; ++j) { float f = sc[4 * gq + j] * 4096.0f + 32768.0f; f = fminf(fmaxf(f, 0.f), 65535.f); v[j] = (unsigned)__float2int_rn(f); }
            u32x2 o; o.x = v[0] | (v[1] << 16); o.y = v[2] | (v[3] << 16);
            *(u32x2*)(scrow + 32 * kt + 8 * gq + 4 * hi) = o; }
    }
}

DI void select_row(int b, int t, const unsigned short* SC, unsigned char* BM, LAS unsigned* hist, int lane) {
    unsigned char* bm = BM + (size_t)(SEQ * b + t) * 512;
    const int n = t + 1;
    if (n <= 240) {
#pragma unroll
        for (int j = 0; j < 8; ++j) { const int k0 = (j * 64 + lane) * 8; int c = n - k0; c = c < 0 ? 0 : (c > 8 ? 8 : c); bm[j * 64 + lane] = (unsigned char)((1u << c) - 1u); }
        return;
    }
    const unsigned short* row = SC + sc_row_off(b, t);
    const int pitch = 256 * ((t >> 8) + 1);
    unsigned key[8][8];
#pragma unroll
    for (int j = 0; j < 8; ++j) { const int k0 = (j * 64 + lane) * 8; u32x4 v = {0u, 0u, 0u, 0u}; if (k0 < pitch) v = *(const u32x4*)(row + k0);
#pragma unroll
        for (int e = 0; e < 4; ++e) { key[j][2 * e] = v[e] & 0xffffu; key[j][2 * e + 1] = v[e] >> 16; } }
    unsigned thr_hi = 0, need = 240;
#pragma unroll 1
    for (int pass = 0; pass < 2; ++pass) {
#pragma unroll
        for (int i = 0; i < 4; ++i) hist[lane * 4 + i] = 0u;
        LDS_WAIT(); asm volatile("" ::: "memory");
#pragma unroll
        for (int j = 0; j < 8; ++j)
#pragma unroll
            for (int e = 0; e < 8; ++e) { const int k = (j * 64 + lane) * 8 + e; const unsigned kv = key[j][e];
                const bool use = (k <= t) && (pass == 0 || (kv >> 8) == thr_hi);
                if (use) __hip_atomic_fetch_add(&hist[pass == 0 ? (kv >> 8) : (kv & 255u)], 1u, __ATOMIC_RELAXED, __HIP_MEMORY_SCOPE_WORKGROUP); }
        LDS_WAIT(); asm volatile("" ::: "memory");
        unsigned c[4], s = 0;
#pragma unroll
        for (int i = 0; i < 4; ++i) { c[i] = hist[lane * 4 + i]; s += c[i]; }
        unsigned suf = s;
#pragma unroll
        for (int o = 1; o < 64; o <<= 1) { const unsigned v = __shfl_down(suf, o); if (lane + o < 64) suf += v; }
        unsigned above = suf - s; int bin = -1; unsigned ab = 0;
#pragma unroll
        for (int i = 3; i >= 0; --i) { if (bin < 0 && above < need && above + c[i] >= need) { bin = lane * 4 + i; ab = above; } above += c[i]; }
        const unsigned long long m = __ballot(bin >= 0); const int src = (int)__builtin_ctzll(m ? m : 1ull);
        const unsigned fb = (unsigned)__shfl(bin, src), fa = __shfl(ab, src);
        if (pass == 0) { thr_hi = fb; need -= fa; } else { thr_hi = (thr_hi << 8) | fb; need -= fa; }
        LDS_WAIT(); asm volatile("" ::: "memory");
    }
    const unsigned thr = thr_hi;
    unsigned eqbase = 0;
#pragma unroll
    for (int j = 0; j < 8; ++j) {
        unsigned ce = 0;
#pragma unroll
        for (int e = 0; e < 8; ++e) { const int k = (j * 64 + lane) * 8 + e; ce += (k <= t && key[j][e] == thr) ? 1u : 0u; }
        unsigned inc = ce;
#pragma unroll
        for (int o = 1; o < 64; o <<= 1) { const unsigned v = __shfl_up(inc, o); if (lane >= o) inc += v; }
        unsigned rank = eqbase + inc - ce;
        eqbase += __shfl(inc, 63);
        unsigned bits = 0;
#pragma unroll
        for (int e = 0; e < 8; ++e) { const int k = (j * 64 + lane) * 8 + e; const unsigned kv = key[j][e]; bool sel = false;
            if (k <= t) { if (kv > thr) sel = true; else if (kv == thr) { sel = rank < need; ++rank; } }
            bits |= sel ? (1u << e) : 0u; }
        bm[j * 64 + lane] = (unsigned char)bits;
    }
}

constexpr int RL_K = 0, RL_V = 32768;
DI void ret_state_unit(LAS unsigned char* lds, int b, int h, int fs, const bf16_t* BKZ, const bf16_t* BV, bf16_t* RS) {
    const int tid = opaque_tid(), lane = tid & 63, hi = lane >> 5, r32 = lane & 31; const int wid = __builtin_amdgcn_readfirstlane(tid >> 6);
    const int db = wid & 3, fb = wid >> 2;
    const float g = exp2f(128.0f * gamma_log2(h));
    f32x16 S = f32x16{};
    const unsigned ldsb = (unsigned)(size_t)lds;
    const int vlane = ((lane >> 4) & 1) * 32 + (lane & 3) * 8 + (4 * hi + ((lane & 15) >> 2)) * 64;
    u32x4 kr[4], vr[2];
#define RET_LOADC(cc_) do { const int row0_ = (cc_) < 0 ? 128 : ROW0 + SEQ * b + 128 * (cc_); \
        _Pragma("unroll") for (int i = 0; i < 4; ++i) { const int idx = tid + 512 * i, piece = idx >> 6, l = idx & 63; const int e = 16 * (piece & 7) + (l >> 2), d = 32 * (piece >> 3) + 8 * (l & 3); \
            kr[i] = *(const u32x4*)(BKZ + (size_t)(row0_ + e) * 512 + 128 * h + d); } \
        _Pragma("unroll") for (int i = 0; i < 2; ++i) { const int idx = tid + 512 * i, piece = idx >> 6, l = idx & 63; const int e = 16 * (piece & 7) + (l >> 2), f = 32 * (piece >> 3) + 8 * (l & 3); \
            vr[i] = *(const u32x4*)(BV + (size_t)(row0_ + e) * 1024 + 256 * h + 64 * fs + f); } } while (0)
    RET_LOADC(-1);
    for (int cc = -1; cc < 31; ++cc) {
#pragma unroll
        for (int i = 0; i < 4; ++i) *(LAS u32x4*)(lds + RL_K + (tid + 512 * i) * 16) = kr[i];
#pragma unroll
        for (int i = 0; i < 2; ++i) *(LAS u32x4*)(lds + RL_V + (tid + 512 * i) * 16) = vr[i];
        __syncthreads();
        if (cc + 1 < 31) RET_LOADC(cc + 1);
        f32x16 kv = f32x16{};
#pragma unroll
        for (int ks = 0; ks < 8; ++ks) { s16x4 al, ah, bl, bh;
            const int ka = (int)ldsb + RL_K + (db * 8 + ks) * 1024 + vlane, va = (int)ldsb + RL_V + (fb * 8 + ks) * 1024 + vlane;
            asm volatile("ds_read_b64_tr_b16 %0,%1" : "=&v"(al) : "v"(ka) : "memory");
            asm volatile("ds_read_b64_tr_b16 %0,%1 offset:512" : "=&v"(ah) : "v"(ka) : "memory");
            asm volatile("ds_read_b64_tr_b16 %0,%1" : "=&v"(bl) : "v"(va) : "memory");
            asm volatile("ds_read_b64_tr_b16 %0,%1 offset:512" : "=&v"(bh) : "v"(va) : "memory");
            asm volatile("s_waitcnt lgkmcnt(0)" ::: "memory"); __builtin_amdgcn_sched_barrier(0);
            const bf16x8 A = {al[0], al[1], al[2], al[3], ah[0], ah[1], ah[2], ah[3]}, B = {bl[0], bl[1], bl[2], bl[3], bh[0], bh[1], bh[2], bh[3]};
            kv = __builtin_amdgcn_mfma_f32_32x32x16_bf16(A, B, kv, 0, 0, 0); }
#pragma unroll
        for (int i = 0; i < 16; ++i) S[i] = S[i] * g + kv[i];
        bf16_t* rp = RS + ((((size_t)(b * 4 + h) * 32 + (cc + 1)) * 256) + 64 * fs + 32 * fb + r32) * 128 + 32 * db + 4 * hi;
#pragma unroll
        for (int gq = 0; gq < 4; ++gq) { u32x2 o; o.x = cvt_pk_bf16(S[4 * gq], S[4 * gq + 1]); o.y = cvt_pk_bf16(S[4 * gq + 2], S[4 * gq + 3]); *(u32x2*)(rp + 8 * gq) = o; }
        __syncthreads();
    }
}

constexpr int RO_K = 0, RO_V = 32768, RO_X = 98304;
DI void ret_out_unit(LAS unsigned char* lds, int b, int h, int c, const bf16_t* BQ, const bf16_t* BKZ, const bf16_t* BV, const bf16_t* RS, bf16_t* CAT, const float* gng) {
    const int tid = opaque_tid(), lane = tid & 63, hi = lane >> 5, r32 = lane & 31; const int wid = __builtin_amdgcn_readfirstlane(tid >> 6);
    const int rb = wid & 3, fh = wid >> 2;
    const int row0 = c < 0 ? 128 : ROW0 + SEQ * b + 128 * c;
    const float lg = gamma_log2(h);
#pragma unroll 1
    for (int i = 0; i < 4; ++i) { const int idx = tid + 512 * i, et = idx >> 10, rem = idx & 1023, dc = rem >> 6, e = rem & 63;
        *(LAS u32x4*)(lds + RO_K + et * 16384 + dc * 1024 + e * 16) = *(const u32x4*)(BKZ + (size_t)(row0 + 64 * et + e) * 512 + 128 * h + 8 * dc); }
    asm volatile("" ::: "memory");
#pragma unroll 2
    for (int i = 0; i < 8; ++i) { const int idx = tid + 512 * i, et = idx >> 11, rem = idx & 2047, piece = rem >> 6, l = rem & 63; const int e = 16 * (piece & 3) + (l >> 2), f = 32 * (piece >> 2) + 8 * (l & 3);
        *(LAS u32x4*)(lds + RO_V + et * 32768 + piece * 1024 + l * 16) = *(const u32x4*)(BV + (size_t)(row0 + 64 * et + e) * 1024 + 256 * h + f); if (i == 3) asm volatile("" ::: "memory"); }
    asm volatile("" ::: "memory");
    bf16x8 qf[8];
#pragma unroll
    for (int s = 0; s < 8; ++s) qf[s] = *(const bf16x8*)(BQ + (size_t)(row0 + 32 * rb + r32) * 512 + 128 * h + 16 * s + 8 * hi);
    f32x16 o[4];
#pragma unroll
    for (int fb = 0; fb < 4; ++fb) o[fb] = f32x16{};
    if (c >= 0) {
        const bf16_t* rs = RS + (((size_t)(b * 4 + h) * 32 + c) * 256 + 128 * fh + r32) * 128 + 8 * hi;
#pragma unroll
        for (int fb = 0; fb < 4; ++fb) {
#pragma unroll
            for (int s = 0; s < 8; ++s) { const bf16x8 rf = *(const bf16x8*)(rs + (size_t)(32 * fb) * 128 + 16 * s); o[fb] = __builtin_amdgcn_mfma_f32_32x32x16_bf16(qf[s], rf, o[fb], 0, 0, 0); }
            asm volatile("" ::: "memory"); }
#pragma unroll
        for (int r = 0; r < 16; ++r) { const float xi = exp2f((float)(32 * rb + att::crow(r, hi) + 1) * lg);
#pragma unroll
            for (int fb = 0; fb < 4; ++fb) o[fb][r] *= xi; }
    }
    __syncthreads();
    const unsigned ldsb = (unsigned)(size_t)lds;
    const int vlane = ((lane >> 4) & 1) * 32 + (lane & 3) * 8 + (4 * hi + ((lane & 15) >> 2)) * 64;
    const int n = 32 * rb + r32;
    const float rowfac = exp2f((float)(n - 127) * lg);
    const int net = rb >= 2 ? 2 : 1;
    for (int et = 0; et < net; ++et) {
        f32x16 p0 = f32x16{}, p1 = f32x16{};
        const LAS unsigned char* kb = lds + RO_K + et * 16384 + hi * 1024 + r32 * 16;
#pragma unroll
        for (int s = 0; s < 8; ++s) { const bf16x8 b0 = *(const LAS bf16x8*)(kb + s * 2048), b1 = *(const LAS bf16x8*)(kb + s * 2048 + 512);
            p0 = __builtin_amdgcn_mfma_f32_32x32x16_bf16(b0, qf[s], p0, 0, 0, 0); p1 = __builtin_amdgcn_mfma_f32_32x32x16_bf16(b1, qf[s], p1, 0, 0, 0); }
#pragma unroll
        for (int r = 0; r < 16; ++r) { const int e0 = 64 * et + att::crow(r, hi); p0[r] = (e0 <= n) ? p0[r] * rowfac : 0.f; p1[r] = (e0 + 32 <= n) ? p1[r] * rowfac : 0.f; }
        const bf16x8 pa[4] = {att::pack8(p0, 0), att::pack8(p0, 8), att::pack8(p1, 0), att::pack8(p1, 8)};
        __builtin_amdgcn_sched_barrier(0);
#pragma unroll
        for (int fb = 0; fb < 4; ++fb) { s16x4 lo[4], hh[4];
            const int va = (int)ldsb + RO_V + et * 32768 + ((4 * fh + fb) * 4) * 1024 + vlane;
#pragma unroll
            for (int ks = 0; ks < 4; ++ks) {
                asm volatile("ds_read_b64_tr_b16 %0,%1 offset:%c2" : "=&v"(lo[ks]) : "v"(va), "i"(ks * 1024) : "memory");
                asm volatile("ds_read_b64_tr_b16 %0,%1 offset:%c2" : "=&v"(hh[ks]) : "v"(va), "i"(ks * 1024 + 512) : "memory"); }
            asm volatile("s_waitcnt lgkmcnt(0)" ::: "memory"); __builtin_amdgcn_sched_barrier(0);
#pragma unroll
            for (int ks = 0; ks < 4; ++ks) { const bf16x8 vf = {lo[ks][0], lo[ks][1], lo[ks][2], lo[ks][3], hh[ks][0], hh[ks][1], hh[ks][2], hh[ks][3]};
                o[fb] = __builtin_amdgcn_mfma_f32_32x32x16_bf16(pa[ks], vf, o[fb], 0, 0, 0); } }
    }
    LAS float* X = (LAS float*)(lds + RO_X);
#pragma unroll
    for (int r = 0; r < 16; ++r) { float a = 0.f, q = 0.f;
#pragma unroll
        for (int fb = 0; fb < 4; ++fb) { a += o[fb][r]; q += o[fb][r] * o[fb][r]; }
#pragma unroll
        for (int m = 1; m < 32; m <<= 1) { a += __shfl_xor(a, m); q += __shfl_xor(q, m); }
        if (r32 == 0) { LAS float* xp = X + (((rb * 2 + fh) * 32) + att::crow(r, hi)) * 2; xp[0] = a; xp[1] = q; } }
    __syncthreads();
    bf16_t* cat = CAT + (size_t)(row0 + 32 * rb) * 1536 + 512 + 256 * h + 128 * fh + r32;
#pragma unroll
    for (int r = 0; r < 16; ++r) { const int nr = att::crow(r, hi);
        const LAS float* xa = X + (((rb * 2 + 0) * 32) + nr) * 2; const LAS float* xb = X + (((rb * 2 + 1) * 32) + nr) * 2;
        const float sum = xa[0] + xb[0], sq = xa[1] + xb[1]; const float mu = sum * (1.0f / 256.0f); float var = sq * (1.0f / 256.0f) - mu * mu; var = var < 0.f ? 0.f : var;
        const float rstd = 1.0f / sqrtf(var + EPS);
#pragma unroll
        for (int fb = 0; fb < 4; ++fb) { bf16_t* p = cat + (size_t)nr * 1536 + 32 * fb; const float gate = bf2f(*p); const float sg = gate / (1.0f + __expf(-gate));
            const float v = (o[fb][r] - mu) * rstd * gng[256 * h + 128 * fh + 32 * fb + r32] * sg; *p = (bf16_t)(cvt_pk_bf16(v, 0.f) & 0xffffu); }
        asm volatile("" ::: "memory"); }
    __syncthreads();
}
#ifndef PH_LO
#define PH_LO 0
#endif
#ifndef PH_HI
#define PH_HI 14
#endif
__global__ void __launch_bounds__(NWAVES * 64, 2) fwd_kernel(Params P) {
    extern __shared__ __attribute__((aligned(16))) unsigned char lds_raw[];
    LAS unsigned char* lds = (LAS unsigned char*)lds_raw;
    volatile LAS unsigned* MISC = (volatile LAS unsigned*)(lds + MISC_OFF);
    const int G = gridDim.x; const int bx = blockIdx.x; const int vcu = (G % 8 == 0) ? (bx % 8) * (G / 8) + bx / 8 : bx;
    const int NGW = G * NWAVES;
#define PHASE_IDS() const int tid = opaque_tid(), lane = tid & 63, wave = __builtin_amdgcn_readfirstlane(tid >> 6), gw = vcu * NWAVES + wave; (void)lane; (void)gw
    unsigned char* ws = P.ws; unsigned char* dob = (unsigned char*)P.out;
    gu32* ctl = (gu32*)(ws + WS_CTL);
    for (int u = threadIdx.x; u < (LDS_BYTES - LDSCTL_OFF) / 4; u += NWAVES * 64) ((LAS unsigned*)(lds + LDSCTL_OFF))[u] = 0u;
    __syncthreads();
    XcdBarrier bar = xcd_barrier_post((unsigned*)(ctl + CW_BAR), MISC + 8);

    float* SSQ = (float*)(ws + WS_SSQ); float* H = (float*)(ws + WS_H); bf16_t* HB = (bf16_t*)(ws + WS_HB);
    bf16_t* AQ = (bf16_t*)(ws + WS_AQ); bf16_t* O1 = (bf16_t*)(ws + WS_O1); bf16_t* AK = (bf16_t*)(ws + WS_AK); bf16_t* AV = (bf16_t*)(ws + WS_AV); bf16_t* IQ = (bf16_t*)(ws + WS_IQ);
    unsigned short* SC = (unsigned short*)(ws + WS_SC); bf16_t* CAT = (bf16_t*)(ws + WS_CAT);
    bf16_t* BQ = (bf16_t*)(ws + WS_BQ); bf16_t* BKZ = (bf16_t*)(ws + WS_BKZ); bf16_t* BV = (bf16_t*)(ws + WS_BV);
    bf16_t* ACT = (bf16_t*)(ws + WS_BIG); bf16_t* Q1 = (bf16_t*)(ws + WS_Q1); bf16_t* K1 = (bf16_t*)(ws + WS_K1); bf16_t* V1 = (bf16_t*)(ws + WS_V1);
    bf16_t* WIN0 = (bf16_t*)(dob + DO_WIN0); bf16_t* RS = (bf16_t*)(dob + DO_RS);
    bf16_t* WOUT0 = (bf16_t*)(dob + DO_WOUT0); bf16_t* WUG0 = (bf16_t*)(dob + DO_WUG0); bf16_t* WDN0 = (bf16_t*)(dob + DO_WDN0);
    bf16_t* WIN1 = (bf16_t*)(dob + DO_WIN1); bf16_t* WOUT1 = (bf16_t*)(dob + DO_WOUT1); bf16_t* WUG1 = (bf16_t*)(dob + DO_WUG1); bf16_t* WDN1 = (bf16_t*)(dob + DO_WDN1);
    unsigned char* BM = dob + DO_BM; f32x2* ROT = (f32x2*)(dob + DO_ROT); bf16_t* IK = (bf16_t*)(dob + DO_IK); float* IW = (float*)(dob + DO_IW);

#define IN(k) (PH_LO <= (k) && (k) < PH_HI)
#ifndef REP_PHASE
#define REP_PHASE -1
#endif
#define REPS(k) for (int rep_ = 0; rep_ < ((k) == REP_PHASE ? 2 : 1); ++rep_, ((k) == REP_PHASE && rep_ == 1 ? xcd_barrier(bar) : (void)0))
#ifdef TS_A
    const unsigned long long ts0 = __builtin_amdgcn_s_memrealtime();
#define SEAM(k) do { if (IN(k) && IN((k) + 1)) xcd_barrier(bar); if (bx == 0 && threadIdx.x == 0) __hip_atomic_store(ctl + 2048 + (k), (unsigned)(__builtin_amdgcn_s_memrealtime() - ts0), RLX_AGENT); } while (0)
#else
#define SEAM(k) do { if (IN(k) && IN((k) + 1)) xcd_barrier(bar); } while (0)
#endif

    if (IN(0)) REPS(0) {
        PHASE_IDS();
        LAS float* scr = (LAS float*)(lds + wave * 16384);
        for (int it = gw; it < 16 * (N0 / 32); it += NGW) transpose_item<1>(P.win0, nullptr, 1024, N0, WIN0, P.nmix, scr, it, lane);
        for (int e = vcu * 512 + tid; e < 4112 * 64; e += G * 512) { const int pos = e >> 6, i = e & 63;
            const float inv = 1.0f / powf(10000.0f, (float)i * (1.0f / 64.0f)); const float ang = (float)pos * inv;
            const double rev = (double)ang * 0.15915494309189535; const float fr = (float)(rev - floor(rev));
            ROT[e] = (f32x2){__builtin_amdgcn_cosf(fr), __builtin_amdgcn_sinf(fr)}; }
        for (int r = gw; r < RT; r += NGW) { const float* src = h0_row(P, r);
            f32x4 v[4]; float s = 0.f;
#pragma unroll
            for (int j = 0; j < 4; ++j) { v[j] = src ? ((const f32x4*)src)[lane + 64 * j] : (f32x4){0.f, 0.f, 0.f, 0.f}; s += (v[j][0] * v[j][0] + v[j][1] * v[j][1]) + (v[j][2] * v[j][2] + v[j][3] * v[j][3]); }
            s = wave_sum(s);
#pragma unroll
            for (int j = 0; j < 4; ++j) { u32x2 o; o.x = cvt_pk_bf16(v[j][0], v[j][1]); o.y = cvt_pk_bf16(v[j][2], v[j][3]); ((u32x2*)(HB + (size_t)r * DM))[lane + 64 * j] = o; }
            if (lane < 16) SSQ[(size_t)r * 16 + lane] = lane == 0 ? s : 0.f; }
    }
    SEAM(0);
    if (IN(1)) REPS(1) {
        pg8::Gemm g{HB, WIN0, 1024}; pg8::SchedPlain S; S.init(NMT, N0 / 256, G, bx, 0);
        EpiG0 E{CAT, AQ, AK, AV, IQ, IK, BQ, BKZ, BV, IW, SSQ, ROT, (LAS float*)(lds + LDSX_OFF + 4096)};
        pg8::gemm_phase(lds, g, S, E);
    }
    SEAM(1);
    if (IN(2)) REPS(2) {
        PHASE_IDS();
        const int nstate = G >= 128 ? 64 : 0;
        if (vcu < nstate) { ret_state_unit(lds, vcu >> 4, (vcu >> 2) & 3, vcu & 3, BKZ, BV, RS); }
        else {
            if (nstate == 0) for (int u = vcu; u < 64; u += G) ret_state_unit(lds, u >> 4, (u >> 2) & 3, u & 3, BKZ, BV, RS);
            const int iw = (vcu - nstate) * NWAVES + wave, niw = (G - nstate) * NWAVES;
            for (int item = iw; item < 576 * NB; item += niw) indexer_item(item, IQ, IK, IW, SC, lane);
        }
    }
    SEAM(2);
    if (IN(3)) REPS(3) {
        PHASE_IDS();
#ifndef NO_RETOUT
        for (int u = vcu; u < 516; u += G) { const int ub = u < 512 ? u >> 7 : 0, uh = u < 512 ? (u >> 5) & 3 : u - 512, uc = u < 512 ? (u & 31) : -1; ret_out_unit(lds, ub, uh, uc, BQ, BKZ, BV, RS, CAT, P.gng); }
#endif
#ifndef NO_SELECT
        LAS unsigned* hist = (LAS unsigned*)(lds + wave * 1024);
        for (int r = gw; r < NB * SEQ; r += NGW) select_row(r >> 12, r & (SEQ - 1), SC, BM, hist, lane);
#endif
    }
    SEAM(3);
    if (IN(4)) REPS(4) {
        PHASE_IDS();
        LAS float* scr = (LAS float*)(lds + wave * 16384);
        constexpr int I0 = 24 * 32, I1 = 16 * 176, I2 = 44 * 32, I3 = 16 * 96, I4 = 16 * 32;
        for (int it = gw; it < I0 + 2 * I1 + 2 * I2 + I3 + I4; it += NGW) { int r = it;
            if (r < I0) { transpose_item<0>(P.wout0, nullptr, 1536, 1024, WOUT0, nullptr, scr, r, lane); continue; } r -= I0;
            if (r < I1) { transpose_item<2>(P.wup, P.wgate, 1024, 5632, WUG0, P.nffn, scr, r, lane); continue; } r -= I1;
            if (r < I2) { transpose_item<0>(P.wdown, nullptr, DFF, 1024, WDN0, nullptr, scr, r, lane); continue; } r -= I2;
            if (r < I3) { transpose_item<0>(P.win1, nullptr, 1024, 3072, WIN1, P.nmix + DM, scr, r, lane); continue; } r -= I3;
            if (r < I4) { transpose_item<0>(P.wout1, nullptr, 1024, 1024, WOUT1, nullptr, scr, r, lane); continue; } r -= I4;
            if (r < I1) { transpose_item<2>(P.wup + (size_t)DM * DFF, P.wgate + (size_t)DM * DFF, 1024, 5632, WUG1, P.nffn + DM, scr, r, lane); continue; } r -= I1;
            transpose_item<0>(P.wdown + (size_t)DFF * DM, nullptr, DFF, 1024, WDN1, nullptr, scr, r, lane); }
        __syncthreads();
        for (int p = vcu; p < 256; p += G)
#pragma unroll 1
            for (int k = 0; k < 3; ++k) { if (k == 2 && p >= 8) break; const int u = k == 1 ? 511 - p : p; const int qb = k == 2 ? -1 : 15 - (u >> 5), bh = u & 31;
                att::attn_unit<0>(lds, AQ, 512, AK, AV, 512, CAT, 1536, k == 2 ? p : (bh & 7), k == 2 ? 0 : (bh >> 3), qb, BM, P.relb); }
    }
    SEAM(4);
    if (IN(5)) REPS(5) {
        PHASE_IDS();
        pg8::Gemm g{CAT, WOUT0, 1536}; pg8::SchedPlain S; S.init(NMT - 1, 4, G, bx, 1);
        EpiResid<true> E{P, HB, SSQ};
        pg8::gemm_phase(lds, g, S, E);
        for (int j = vcu; j < 16; j += G) skinny_job<true, true>(lds, CAT, WOUT0, 1536, j, P, H, HB, SSQ, nullptr);
        for (int i = vcu * 512 + tid; i < MROW * DM * 2 / 16; i += G * 512) ((u32x4*)HB)[i] = (u32x4){0u, 0u, 0u, 0u};
    }
    SEAM(5);
    if (IN(6)) REPS(6) {
        pg8::Gemm g{HB, WUG0, 1024}; pg8::SchedFfn S; S.init(G, bx);
        EpiFfn E{ACT, SSQ, P.convw, P.convb, (LAS float*)(lds + LDSX_OFF), (LAS float*)(lds + LDSX_OFF + 4096)};
        pg8::gemm_phase(lds, g, S, E);
    }
    SEAM(6);
    if (IN(7)) REPS(7) {
        pg8::Gemm g{ACT, WDN0, DFF}; pg8::SchedPlain S; S.init(NMT - 1, 4, G, bx, 1);
        EpiResid<false> E{P, HB, SSQ};
        pg8::gemm_phase(lds, g, S, E);
        for (int j = vcu; j < 16; j += G) skinny_job<true, false>(lds, ACT, WDN0, DFF, j, P, H, HB, SSQ, nullptr);
    }
    SEAM(7);
    if (IN(8)) REPS(8) {
        PHASE_IDS();
        pg8::Gemm g{HB, WIN1, 1024}; pg8::SchedPlain S; S.init(NMT - 1, 12, G, bx, 1);
        EpiQKV1 E{Q1, K1, V1, SSQ, (LAS float*)(lds + LDSX_OFF + 4096)};
        pg8::gemm_phase(lds, g, S, E);
        for (int j = vcu; j < 48; j += G) skinny_job<false, false>(lds, HB, WIN1, 1024, j, P, H, HB, SSQ, Q1);
        for (int i = vcu * 512 + tid; i < 3 * 48 * DM * 2 / 16; i += G * 512) { const int seg = i / (48 * 128), r = i % (48 * 128); ((u32x4*)(Q1 + (size_t)seg * ((WS_K1 - WS_Q1) / 2) + (size_t)192 * DM))[r] = (u32x4){0u, 0u, 0u, 0u}; }
    }
    SEAM(8);
    if (IN(9)) REPS(9) {
        for (int u = vcu; u < 1040; u += G) { const int bh = u & 63; const int uh = u < 1024 ? (bh & 15) : u - 1024, ub = u < 1024 ? (bh >> 4) : 0, uq = u < 1024 ? 15 - (u >> 6) : -1;
            att::attn_unit<1>(lds, Q1, 1024, K1, V1, 1024, O1, 1024, uh, ub, uq, nullptr, nullptr); }
    }
    SEAM(9);
    if (IN(10)) REPS(10) {
        pg8::Gemm g{O1, WOUT1, 1024}; pg8::SchedPlain S; S.init(NMT - 1, 4, G, bx, 1);
        EpiResid<false> E{P, HB, SSQ};
        pg8::gemm_phase(lds, g, S, E);
        for (int j = vcu; j < 16; j += G) skinny_job<true, false>(lds, O1, WOUT1, 1024, j, P, H, HB, SSQ, nullptr);
    }
    SEAM(10);
    if (IN(11)) REPS(11) {
        pg8::Gemm g{HB, WUG1, 1024}; pg8::SchedFfn S; S.init(G, bx);
        EpiFfn E{ACT, SSQ, P.convw + 3 * DFF, P.convb + DFF, (LAS float*)(lds + LDSX_OFF), (LAS float*)(lds + LDSX_OFF + 4096)};
        pg8::gemm_phase(lds, g, S, E);
    }
    SEAM(11);
    if (IN(12)) REPS(12) {
        pg8::Gemm g{ACT, WDN1, DFF}; pg8::SchedPlain S; S.init(NMT - 1, 4, G, bx, 1);
        EpiResid<false> E{P, HB, SSQ};
        pg8::gemm_phase(lds, g, S, E);
        for (int j = vcu; j < 16; j += G) skinny_job<true, false>(lds, ACT, WDN1, DFF, j, P, H, HB, SSQ, nullptr);
    }
    SEAM(12);
    if (IN(13)) REPS(13) {
        PHASE_IDS();
        for (int r = ROW0 + gw; r < RT; r += NGW) { const float rn = row_rnorm(SSQ, r); const u32x4* hp = (const u32x4*)(HB + (size_t)r * DM); f32x4* op = (f32x4*)(P.out + (size_t)(r - ROW0) * DM);
#pragma unroll
            for (int j = 0; j < 2; ++j) { const u32x4 hb = hp[lane + 64 * j]; const f32x4 g0 = ((const f32x4*)P.nfin)[2 * (lane + 64 * j)], g1 = ((const f32x4*)P.nfin)[2 * (lane + 64 * j) + 1];
                const f32x4 v0 = {__uint_as_float(hb.x << 16), __uint_as_float(hb.x & 0xffff0000u), __uint_as_float(hb.y << 16), __uint_as_float(hb.y & 0xffff0000u)};
                const f32x4 v1 = {__uint_as_float(hb.z << 16), __uint_as_float(hb.z & 0xffff0000u), __uint_as_float(hb.w << 16), __uint_as_float(hb.w & 0xffff0000u)};
                op[2 * (lane + 64 * j)] = v0 * rn * g0; op[2 * (lane + 64 * j) + 1] = v1 * rn * g1; } }
    }
#ifdef TS_A
    xcd_barrier(bar);
    if (bx == 0 && threadIdx.x == 0) __hip_atomic_store(ctl + 2048 + 13, (unsigned)(__builtin_amdgcn_s_memrealtime() - ts0), RLX_AGENT);
    xcd_barrier(bar);
    { const unsigned a1 = __hip_atomic_load(ctl + 2048 + TS_A, RLX_AGENT), a0 = TS_A > 0 ? __hip_atomic_load(ctl + 2048 + TS_A - 1, RLX_AGENT) : 0u;
      const unsigned b1 = __hip_atomic_load(ctl + 2048 + TS_B, RLX_AGENT), b0 = TS_B > 0 ? __hip_atomic_load(ctl + 2048 + TS_B - 1, RLX_AGENT) : 0u;
      const float da = (float)(a1 - a0) * 0.01f, db = (float)(b1 - b0) * 0.01f;
      if (bx == 0 && threadIdx.x == 0) P.out[0] += da;
      for (int i = bx * 512 + threadIdx.x; i < (1 << 20); i += G * 512) P.out[16 + i] += db * 0.01f; }
#endif
#undef IN
#undef SEAM
}

extern "C" void kernel_launch(void* const* d_in, const int* in_sizes, int n_in, void* d_out, int out_size, void* d_ws, size_t ws_size, hipStream_t stream) {
    static int grid = 0;
    if (grid == 0) {
        if (n_in != 16 || in_sizes[0] != NB * SEQ * DM || out_size != NB * SEQ * DM || ws_size < WS_END) { fprintf(stderr, "kernel_launch: unexpected shapes (n_in %d, in0 %d, out %d, ws %zu); nothing launched\n", n_in, n_in > 0 ? in_sizes[0] : -1, out_size, ws_size); grid = -1; return; }
        int dev = 0, cus = 0, per_cu = 0;
        if (hipGetDevice(&dev) != hipSuccess || hipDeviceGetAttribute(&cus, hipDeviceAttributeMultiprocessorCount, dev) != hipSuccess) { fprintf(stderr, "kernel_launch: device query failed\n"); grid = -1; return; }
        if (hipFuncSetAttribute((const void*)fwd_kernel, hipFuncAttributeMaxDynamicSharedMemorySize, LDS_BYTES) != hipSuccess) { fprintf(stderr, "kernel_launch: hipFuncSetAttribute failed\n"); grid = -1; return; }
        if (hipOccupancyMaxActiveBlocksPerMultiprocessor(&per_cu, (const void*)fwd_kernel, NWAVES * 64, LDS_BYTES) != hipSuccess || per_cu < 1) fprintf(stderr, "kernel_launch: note: occupancy query reports %d workgroups per CU\n", per_cu);
        (void)hipGetLastError();
        grid = cus;
    }
    if (grid < 0) return;
    if (hipMemsetAsync((char*)d_ws + WS_CTL, 0, CTL_ZERO_BYTES, stream) != hipSuccess) { fprintf(stderr, "kernel_launch: hipMemsetAsync failed\n"); return; }
    Params p{};
    p.x = (const float*)d_in[0]; p.meta = (const float*)d_in[1]; p.relb = (const float*)d_in[2]; p.nmix = (const float*)d_in[3]; p.nffn = (const float*)d_in[4]; p.nfin = (const float*)d_in[5];
    p.win0 = (const float*)d_in[6]; p.gng = (const float*)d_in[7]; p.wout0 = (const float*)d_in[8]; p.win1 = (const float*)d_in[9]; p.wout1 = (const float*)d_in[10];
    p.wup = (const float*)d_in[11]; p.wgate = (const float*)d_in[12]; p.convw = (const float*)d_in[13]; p.convb = (const float*)d_in[14]; p.wdown = (const float*)d_in[15];
    p.out = (float*)d_out; p.ws = (unsigned char*)d_ws; p.ph_lo = PH_LO; p.ph_hi = PH_HI;
    hipLaunchKernelGGL(fwd_kernel, dim3(grid), dim3(NWAVES * 64), LDS_BYTES, stream, p);
    const hipError_t le = hipPeekAtLastError();
    if (le != hipSuccess) fprintf(stderr, "kernel_launch: launch failed: %s\n", hipGetErrorName(le));
}
```

```cpp
#include <hip/hip_runtime.h>
#include <hip/hip_bf16.h>
#include <cstdio>
#include <cstdint>
#include <cmath>

#define LAS __attribute__((address_space(3)))
#define GAS __attribute__((address_space(1)))
typedef unsigned short bf16_t;
typedef short bf16x8 __attribute__((ext_vector_type(8)));
typedef short s16x4 __attribute__((ext_vector_type(4)));
typedef float f32x4 __attribute__((ext_vector_type(4)));
typedef float f32x2 __attribute__((ext_vector_type(2)));
typedef float f32x16 __attribute__((ext_vector_type(16)));
typedef unsigned u32x4 __attribute__((ext_vector_type(4)));
typedef unsigned u32x2 __attribute__((ext_vector_type(2)));
typedef __bf16 bf16x2_t __attribute__((ext_vector_type(2)));
#define DI __device__ __forceinline__

constexpr int DM = 1024, NB = 4, SEQ = 4096, NMETA = 16, DFF = 2816;
constexpr int ROW0 = 256;
constexpr int MROW = 240;
constexpr int RT = ROW0 + NB * SEQ;
constexpr int NMT = RT / 256;
constexpr float EPS = 1e-6f;
constexpr float LOG2E = 1.4426950408889634f;
constexpr float LN2 = 0.6931471805599453f;
constexpr float C2 = 0.125f * LOG2E;
constexpr int N0 = 5376;
constexpr int NWAVES = 8;

DI unsigned cvt_pk_bf16(float lo, float hi) { f32x2 v = {lo, hi}; bf16x2_t b = __builtin_convertvector(v, bf16x2_t); return __builtin_bit_cast(unsigned, b); }
DI float bf2f(unsigned short u) { return __uint_as_float((unsigned)u << 16); }
DI float wave_sum(float v) {
#pragma unroll
    for (int o = 1; o < 64; o <<= 1) v += __shfl_xor(v, o);
    return v;
}
DI int opaque_tid() { int t = threadIdx.x; asm volatile("" : "+v"(t)); return t; }
#define LDS_WAIT() asm volatile("s_waitcnt lgkmcnt(0)" ::: "memory")
#define VM_WAIT() asm volatile("s_waitcnt vmcnt(0)" ::: "memory")

namespace pg8 {
constexpr int BM = 256, BK = 64, HALF = 128, HTB = HALF * BK * 2, STAGE_BYTES = 8 * HTB, NXCD = 8, WGM = 8;
__host__ __device__ __forceinline__ int lds_byte(int r, int c) { const int st = (r >> 4) * 2 + (c >> 5), rr = r & 15, cc = c & 31, ob = rr * 64 + cc * 2; return st * 1024 + (ob ^ (((ob >> 9) & 1) << 5)); }
__host__ __device__ __forceinline__ void stage_rc(int b, int& R, int& C) { const int st = b / 1024, sb = b % 1024, swz = sb ^ (((sb >> 9) & 1) << 5); R = (st >> 1) * 16 + swz / 64; C = (st & 1) * 32 + (swz % 64) / 2; }
__host__ __device__ __forceinline__ int perm32(int rho) { const int n = rho >> 4, i = rho & 15; return 8 * (i >> 2) + 4 * n + (i & 3); }

struct Unit { int pm, pn, arow, hrow; };
struct Gemm { const bf16_t* A; const bf16_t* Bt; int K; };

struct Order {
    int nM, nN, nwg, G, c;
    DI void init(int nM_, int nN_, int G_, int c_) { nM = nM_; nN = nN_; nwg = nM * nN; G = G_; c = c_; }
    DI bool tile(int i, int& pm, int& pn) const {
        const long L = (long)i * G + c; if (L >= nwg) return false;
        int wgid = (int)L; { const int q = nwg / NXCD, r = nwg % NXCD, xcd = wgid % NXCD, off = wgid / NXCD; wgid = (xcd < r ? xcd * (q + 1) : r * (q + 1) + (xcd - r) * q) + off; }
        const int nig = WGM * nN, gid = wgid / nig, fm = gid * WGM, gsz = (nM - fm) < WGM ? (nM - fm) : WGM;
        pm = fm + ((wgid % nig) % gsz); pn = (wgid % nig) / gsz; return true;
    }
};
struct SchedPlain {
    static constexpr bool HALO = false;
    Order o; int pm0;
    DI void init(int nM, int nN, int G, int c, int pm0_) { o.init(nM, nN, G, c); pm0 = pm0_; }
    DI bool next(int i, Unit& u) const { int pm, pn; if (!o.tile(i, pm, pn)) return false; u.pm = pm + pm0; u.pn = pn; u.arow = (pm + pm0) * 256; u.hrow = u.arow; return true; }
};
struct SchedFfn {
    static constexpr bool HALO = true;
    Order o;
    DI void init(int G, int c) { o.init(1 + 17 * NB, 22, G, c); }
    DI bool next(int i, Unit& u) const { int pm, pn; if (!o.tile(i, pm, pn)) return false; u.pm = pm; u.pn = pn;
        if (pm == 0) { u.arow = 0; u.hrow = 0; } else { const int b = (pm - 1) / 17, ii = (pm - 1) % 17; u.arow = ROW0 + SEQ * b + 254 * ii - 2; u.hrow = (ii == 0 && b > 0) ? (ROW0 - 2) : u.arow; }
        return true; }
};

template <class Epi, class Sched>
__device__ __forceinline__ void gemm_phase(LAS unsigned char* lds, const Gemm g, const Sched& S, const Epi& E) {
    const int tid = opaque_tid(), wid = __builtin_amdgcn_readfirstlane(tid >> 6), lane = tid & 63, wr = wid >> 2, wc = wid & 3, fr = lane & 15, fq = lane >> 4;
    const int K = g.K, nt = K / BK;
    unsigned voffA[2], voffB[2]; bool hsel[2];
#pragma unroll
    for (int i = 0; i < 2; ++i) { int R, C; stage_rc(tid * 16 + i * 8192, R, C); const int Rb = (R & ~31) + perm32(R & 31);
        voffA[i] = (unsigned)(R * K + C) * 2u; voffB[i] = (unsigned)(Rb * K + C) * 2u; hsel[i] = (R < 2); }
    const size_t kstep = (size_t)(BK * 2);
    const size_t hstep = (size_t)HALF * K * 2;
    const size_t tstep = 2 * hstep;
    const size_t rstep = (size_t)K * 2;
    const unsigned ldsw = (unsigned)wid * 1024u;
    const int aoff = lds_byte(wr * 64 + fr, fq * 8), boff = lds_byte(wc * 32 + fr, fq * 8);
#define PG8_SA(b, h) (((b) * 2 + (h)) * HTB)
#define PG8_SB(b, h) ((4 + (b) * 2 + (h)) * HTB)
#define PG8_STAGE(bufoff, gbase, voff) do { _Pragma("unroll") for (int _i = 0; _i < 2; ++_i) \
        __builtin_amdgcn_global_load_lds((const unsigned*)((const char*)(gbase) + (voff)[_i]), (LAS unsigned*)(lds + (bufoff) + ldsw + _i * 8192), 16, 0, 0); } while (0)
#define PG8_STAGE_A0(bufoff, gbase, dl) do { if constexpr (Sched::HALO) { _Pragma("unroll") for (int _i = 0; _i < 2; ++_i) \
        __builtin_amdgcn_global_load_lds((const unsigned*)((const char*)(gbase) + voffA[_i] + (hsel[_i] ? (dl) : (long)0)), (LAS unsigned*)(lds + (bufoff) + ldsw + _i * 8192), 16, 0, 0); } \
        else { PG8_STAGE(bufoff, gbase, voffA); } } while (0)
#define PG8_LDA(dst, b, h) do { _Pragma("unroll") for (int m = 0; m < 4; ++m) _Pragma("unroll") for (int k = 0; k < 2; ++k) dst[m][k] = *(const LAS bf16x8*)(lds + PG8_SA(b, h) + aoff + m * 2048 + k * 1024); } while (0)
#define PG8_LDB(dst, b, h) do { _Pragma("unroll") for (int n = 0; n < 2; ++n) _Pragma("unroll") for (int k = 0; k < 2; ++k) dst[n][k] = *(const LAS bf16x8*)(lds + PG8_SB(b, h) + boff + n * 2048 + k * 1024); } while (0)
#define PG8_MMA(ai, bj, At, Bt) do { __builtin_amdgcn_s_setprio(1); _Pragma("unroll") for (int m = 0; m < 4; ++m) _Pragma("unroll") for (int n = 0; n < 2; ++n) _Pragma("unroll") for (int k = 0; k < 2; ++k) \
        acc[ai][bj][m][n] = __builtin_amdgcn_mfma_f32_16x16x32_bf16(Bt[n][k], At[m][k], acc[ai][bj][m][n], 0, 0, 0); __builtin_amdgcn_s_setprio(0); } while (0)
#define PG8_WAIT_V(n) asm volatile("s_waitcnt vmcnt(" #n ")" ::: "memory")
#define PG8_WAIT_L(n) asm volatile("s_waitcnt lgkmcnt(" #n ")" ::: "memory")
#define PG8_BAR __builtin_amdgcn_s_barrier()
#define PG8_SCHED __builtin_amdgcn_sched_barrier(0)
    Unit cur, nxt; int ui = 0;
    if (!S.next(0, cur)) return;
    f32x4 acc[2][2][4][2];
#pragma unroll
    for (int a = 0; a < 2; ++a)
#pragma unroll
        for (int b = 0; b < 2; ++b)
#pragma unroll
            for (int m = 0; m < 4; ++m)
#pragma unroll
                for (int n = 0; n < 2; ++n) acc[a][b][m][n] = (f32x4){0.f, 0.f, 0.f, 0.f};
    bf16x8 At[4][2], B0[2][2], B1[2][2];
    const char* cA = (const char*)g.A + (size_t)cur.arow * rstep; const char* cB = (const char*)g.Bt + (size_t)cur.pn * tstep;
    long dc = (long)(cur.hrow - cur.arow) * (long)rstep;
    PG8_STAGE(PG8_SB(0, 0), cB, voffB); PG8_STAGE(PG8_SB(0, 1), cB + hstep, voffB); PG8_STAGE_A0(PG8_SA(0, 0), cA, dc); PG8_STAGE(PG8_SA(0, 1), cA + hstep, voffA);
    if (wr == 1) PG8_BAR;
    PG8_WAIT_V(2); PG8_BAR;
    PG8_STAGE(PG8_SB(1, 0), cB + kstep, voffB); PG8_STAGE_A0(PG8_SA(1, 0), cA + kstep, dc); PG8_STAGE(PG8_SB(1, 1), cB + hstep + kstep, voffB);
    PG8_WAIT_V(6); PG8_BAR;
    for (;;) {
        const bool has_next = S.next(ui + 1, nxt);
        const char* nA = has_next ? (const char*)g.A + (size_t)nxt.arow * rstep : cA; const char* nB = has_next ? (const char*)g.Bt + (size_t)nxt.pn * tstep : cB;
        const long dn = has_next ? (long)(nxt.hrow - nxt.arow) * (long)rstep : dc;
        for (int t = 0; t < nt; t += 2) {
            const bool last = (t == nt - 2);
            const char* a1 = cA + (size_t)(t + 1) * kstep;
            const char* a2 = last ? nA : cA + (size_t)(t + 2) * kstep; const char* b2 = last ? nB : cB + (size_t)(t + 2) * kstep;
            const char* a3 = a2 + kstep; const char* b3 = b2 + kstep;
            const long d2 = last ? dn : dc;
            PG8_LDB(B0, 0, 0); PG8_LDB(B1, 0, 1); PG8_SCHED; PG8_LDA(At, 0, 0); PG8_STAGE(PG8_SA(1, 1), a1 + hstep, voffA);
            PG8_WAIT_V(8); PG8_WAIT_L(0); PG8_BAR; PG8_MMA(0, 0, At, B0); PG8_MMA(0, 1, At, B1); PG8_BAR; PG8_SCHED;
            PG8_LDA(At, 0, 1); PG8_STAGE(PG8_SB(0, 0), b2, voffB); PG8_STAGE(PG8_SB(0, 1), b2 + hstep, voffB); PG8_STAGE_A0(PG8_SA(0, 0), a2, d2);
            PG8_WAIT_V(8); PG8_WAIT_L(0); PG8_BAR; PG8_MMA(1, 0, At, B0); PG8_MMA(1, 1, At, B1); PG8_BAR; PG8_SCHED;
            PG8_LDB(B0, 1, 0); PG8_LDB(B1, 1, 1); PG8_SCHED; PG8_LDA(At, 1, 0); PG8_STAGE(PG8_SA(0, 1), a2 + hstep, voffA);
            PG8_WAIT_V(8); PG8_WAIT_L(0); PG8_BAR; PG8_MMA(0, 0, At, B0); PG8_MMA(0, 1, At, B1); PG8_BAR; PG8_SCHED;
            PG8_LDA(At, 1, 1); PG8_STAGE(PG8_SB(1, 0), b3, voffB); PG8_STAGE(PG8_SB(1, 1), b3 + hstep, voffB); PG8_STAGE_A0(PG8_SA(1, 0), a3, d2);
            PG8_WAIT_V(8); PG8_WAIT_L(0); PG8_BAR; PG8_MMA(1, 0, At, B0); PG8_MMA(1, 1, At, B1); PG8_BAR; PG8_SCHED;
        }
        if (wr == 0) PG8_BAR;
        E(acc, cur, wr, wc, fr, fq, wid, lane);
        if (!has_next) break;
#pragma unroll
        for (int a = 0; a < 2; ++a)
#pragma unroll
            for (int b = 0; b < 2; ++b)
#pragma unroll
                for (int m = 0; m < 4; ++m)
#pragma unroll
                    for (int n = 0; n < 2; ++n) acc[a][b][m][n] = (f32x4){0.f, 0.f, 0.f, 0.f};
        cur = nxt; cA = nA; cB = nB; dc = dn; ++ui;
        if (wr == 1) PG8_BAR;
    }
    PG8_WAIT_V(0);
    PG8_BAR;
#undef PG8_SA
#undef PG8_SB
#undef PG8_STAGE
#undef PG8_STAGE_A0
#undef PG8_LDA
#undef PG8_LDB
#undef PG8_MMA
#undef PG8_WAIT_V
#undef PG8_WAIT_L
#undef PG8_BAR
#undef PG8_SCHED
}
}
constexpr size_t MiB = 1u << 20;
constexpr size_t WS_CTL = 0, CTL_ZERO_BYTES = 64 * 1024;
constexpr size_t WS_SSQ = 1 * MiB;
constexpr size_t WS_AK = 3 * MiB, WS_AV = 20 * MiB, WS_IQ = 37 * MiB;
constexpr size_t WS_H = 3 * MiB;
constexpr size_t WS_SC = 54 * MiB;
constexpr size_t WS_HB = 69 * MiB;
constexpr size_t WS_CAT = 122 * MiB;
constexpr size_t WS_BQ = 171 * MiB, WS_BKZ = 188 * MiB;
constexpr size_t WS_BV = 205 * MiB;
constexpr size_t WS_BIG = 104 * MiB;
constexpr size_t WS_Q1 = 104 * MiB, WS_K1 = 137 * MiB, WS_V1 = 170 * MiB;
constexpr size_t WS_AQ = 238 * MiB;
constexpr size_t WS_O1 = 204 * MiB;
constexpr size_t WS_END = 256 * MiB;
static_assert(WS_AQ + (size_t)RT * 1024 <= WS_END && WS_O1 + (size_t)RT * 2048 <= WS_AQ, "ws map 5");
static_assert(WS_SSQ + (size_t)RT * 64 <= WS_AK && WS_IQ + (size_t)RT * 1024 <= WS_SC && WS_H + (size_t)RT * 4096 <= WS_HB, "ws map 1");
static_assert(WS_SC + 71303168 <= WS_CAT && WS_HB + (size_t)(RT + 1024) * 2048 <= WS_BIG && WS_CAT + (size_t)RT * 3072 <= WS_BQ, "ws map 2");
static_assert(WS_BQ + (size_t)RT * 1024 <= WS_BKZ && WS_BKZ + (size_t)RT * 1024 <= WS_BV && WS_BV + (size_t)RT * 2048 <= WS_END, "ws map 3");
static_assert(WS_BIG + (size_t)RT * DFF * 2 <= WS_END && WS_Q1 + (size_t)RT * 2048 <= WS_K1 && WS_K1 + (size_t)RT * 2048 <= WS_V1 && WS_V1 + (size_t)RT * 2048 <= WS_END, "ws map 4");
constexpr size_t DO_WIN0 = 0;
constexpr size_t DO_RS = 0;
constexpr size_t DO_WOUT0 = 0, DO_WUG0 = 3 * MiB, DO_WDN0 = 14 * MiB, DO_WIN1 = 20 * MiB, DO_WOUT1 = 26 * MiB;
constexpr size_t DO_BM = 32 * MiB;
constexpr size_t DO_ROT = 40 * MiB;
constexpr size_t DO_IK = 43 * MiB;
constexpr size_t DO_IW = 46 * MiB;
constexpr size_t DO_WUG1 = 47 * MiB, DO_WDN1 = 58 * MiB;
static_assert(DO_WDN1 + (size_t)1024 * DFF * 2 <= 64 * MiB && DO_WOUT1 + 2 * MiB <= DO_BM && DO_ROT + 4112 * 64 * 8 <= DO_IK && DO_IK + (size_t)RT * 128 <= DO_IW && DO_IW + (size_t)RT * 32 <= DO_WUG1, "d_out map");
constexpr int CW_TMO = 0, CW_BAR = 1024;
constexpr size_t SC_BATCH = 8912896;

constexpr int RING_BYTES = 131072;
constexpr int LDSX_OFF = RING_BYTES;
constexpr int LDSCTL_OFF = RING_BYTES + 8192, MISC_OFF = LDSCTL_OFF + 320;
constexpr int LDS_BYTES = 147456;

typedef GAS unsigned gu32;
#define RLX_AGENT __ATOMIC_RELAXED, __HIP_MEMORY_SCOPE_AGENT

#define XB_TMO      128
#define XB_XCNT(j)  (256  + 64 * (j))
#define XB_XSUB(j)  (1280 + 64 * (j))
#define XB_XGEN(j)  (2304 + 64 * (j))
#define XB_TOP      3328
#define XB_TOPGEN   3392
#define XCD_BAR_WORDS 3456
#define XB_SPIN_CAP (1u << 18)
DI unsigned xb_ld(unsigned* p)              { return __hip_atomic_load(p, __ATOMIC_RELAXED, __HIP_MEMORY_SCOPE_AGENT); }
DI unsigned xb_add(unsigned* p, unsigned v) { return __hip_atomic_fetch_add(p, v, __ATOMIC_RELAXED, __HIP_MEMORY_SCOPE_AGENT); }
DI unsigned xb_xcc_id() { return (unsigned)__builtin_amdgcn_s_getreg((3 << 11) | 20) & 0xFu; }
#define XB_SPIN(cond, bar) do { unsigned _sp = 0; while (cond) { __builtin_amdgcn_s_sleep(1); \
    if ((++_sp & 255u) == 0u) { if (xb_ld(&(bar)[XB_TMO])) break; if (_sp > XB_SPIN_CAP) { atomicAdd(&(bar)[XB_TMO], 1u); break; } } } } while (0)
struct XcdBarrier { unsigned* bar; unsigned x; volatile LAS unsigned* st; };
DI XcdBarrier xcd_barrier_post(unsigned* bar, volatile LAS unsigned* st) {
    XcdBarrier b; b.bar = bar; b.x = xb_xcc_id(); b.st = st;
    if (threadIdx.x == 0) (void)xb_add(&bar[XB_XCNT(b.x)], 1u);
    return b;
}
DI void xcd_barrier_complete(unsigned* bar, unsigned x, unsigned& nloc, unsigned& nx) {
    const unsigned G = gridDim.x * gridDim.y * gridDim.z;
    unsigned sum, cnt, mine, sp = 0u;
    for (;;) {
        sum = 0u; cnt = 0u; mine = 0u;
#pragma unroll
        for (unsigned j = 0; j < 16; ++j) { const unsigned c = xb_ld(&bar[XB_XCNT(j)]); sum += c; cnt += (c > 0u) ? 1u : 0u; mine = (j == x) ? c : mine; }
        if (sum == G) break;
        __builtin_amdgcn_s_sleep(1);
        if ((++sp & 255u) == 0u) { if (xb_ld(&bar[XB_TMO])) break; if (sp > XB_SPIN_CAP) { atomicAdd(&bar[XB_TMO], 1u); break; } }
    }
    nloc = mine > 0u ? mine : 1u; nx = cnt > 0u ? cnt : 1u;
}
DI void xcd_barrier(const XcdBarrier& b) {
    asm volatile("s_waitcnt vmcnt(0)" ::: "memory");
    __syncthreads();
    if (threadIdx.x == 0) {
        unsigned* bar = b.bar;
        __builtin_amdgcn_s_waitcnt(0);
        unsigned nloc = b.st[0], nx = b.st[1];
        if (nloc == 0u) { xcd_barrier_complete(bar, b.x, nloc, nx); b.st[0] = nloc; b.st[1] = nx; }
        const unsigned old = xb_add(&bar[XB_XSUB(b.x)], 1u);
        const unsigned gen = old / nloc;
        if (old + 1u == (gen + 1u) * nloc) {
            __builtin_amdgcn_fence(__ATOMIC_RELEASE, "agent");
            asm volatile("s_waitcnt vmcnt(0)" ::: "memory");
            const unsigned og = xb_add(&bar[XB_TOP], 1u);
            const unsigned tg = og / nx;
            if (og + 1u == (tg + 1u) * nx) xb_add(&bar[XB_TOPGEN], 1u);
            else XB_SPIN(xb_ld(&bar[XB_TOPGEN]) == tg, bar);
            __builtin_amdgcn_fence(__ATOMIC_ACQUIRE, "agent");
            xb_add(&bar[XB_XGEN(b.x)], 1u);
            asm volatile("s_waitcnt vmcnt(0)" ::: "memory");
        } else {
            XB_SPIN(xb_ld(&bar[XB_XGEN(b.x)]) == gen, bar);
            __builtin_amdgcn_fence(__ATOMIC_ACQUIRE, "agent");
            asm volatile("s_waitcnt vmcnt(0)" ::: "memory");
        }
    }
    __syncthreads();
}

struct Params {
    const float* x; const float* meta; const float* relb; const float* nmix; const float* nffn; const float* nfin;
    const float* win0; const float* gng; const float* wout0; const float* win1; const float* wout1;
    const float* wup; const float* wgate; const float* convw; const float* convb; const float* wdown;
    float* out; unsigned char* ws; int ph_lo, ph_hi;
};

DI int g0_src(int n) {
    const int pn = n >> 8, c = n & 255;
    if (pn < 8) return n;
    if (pn == 8) return c < 64 ? 2048 + c : (c < 72 ? 2112 + (c - 64) : -1);
    if (pn < 13) { const int base = pn < 11 ? 2120 : 2632, t = pn < 11 ? pn - 9 : pn - 11, half = c >> 7, cc = c & 127; return base + 128 * (2 * t + (cc >> 6)) + 64 * half + (cc & 63); }
    if (pn < 17) return 3144 + 256 * (pn - 13) + c;
    return 4168 + 256 * (pn - 17) + c;
}
template <int MODE>
DI void transpose_item(const float* W, const float* W2, int K, int N, bf16_t* WT, const float* gain, LAS float* scr, int item, int lane) {
    const int nblk = N / 32, kb = item / nblk, nb = item % nblk, k0 = 64 * kb, n0 = 32 * nb;
    const int n = n0 + (lane & 31);
    const float* src = W; int sc = n, ld = N;
    if (MODE == 1) { sc = g0_src(n); ld = 5192; }
    if (MODE == 2) { const int j = n >> 8, c = n & 255; if (c < 128) { sc = 128 * j + c; } else { src = W2; sc = 128 * j + c - 128; } ld = DFF; }
    float tv[32];
#pragma unroll
    for (int i = 0; i < 32; ++i) { const int kk = 2 * i + (lane >> 5); tv[i] = (sc >= 0) ? src[(size_t)(k0 + kk) * ld + sc] : 0.f; }
#pragma unroll
    for (int i = 0; i < 32; ++i) { const int kk = 2 * i + (lane >> 5); float v = tv[i]; if (gain) v *= gain[k0 + kk]; scr[kk * 33 + (lane & 31)] = v; }
    LDS_WAIT(); asm volatile("" ::: "memory");
    const int c = lane & 7;
#pragma unroll
    for (int j = 0; j < 4; ++j) { const int nn = (lane >> 3) + 8 * j; const LAS float* s = scr + (8 * c) * 33 + nn;
        u32x4 o; o.x = cvt_pk_bf16(s[0 * 33], s[1 * 33]); o.y = cvt_pk_bf16(s[2 * 33], s[3 * 33]); o.z = cvt_pk_bf16(s[4 * 33], s[5 * 33]); o.w = cvt_pk_bf16(s[6 * 33], s[7 * 33]);
        *(u32x4*)(WT + (size_t)(n0 + nn) * K + k0 + 8 * c) = o; }
    LDS_WAIT(); asm volatile("" ::: "memory");
}
DI const float* h0_row(const Params& P, int r) { return r < MROW ? nullptr : (r < ROW0 ? P.meta + (size_t)(r - MROW) * DM : P.x + (size_t)(r - ROW0) * DM); }
DI float row_rnorm(const float* ssq, int r) {
    const f32x4* p = (const f32x4*)(ssq + (size_t)r * 16); const f32x4 a = p[0], b = p[1], c = p[2], d = p[3];
    const float s = ((a.x + a.y) + (a.z + a.w)) + ((b.x + b.y) + (b.z + b.w)) + ((c.x + c.y) + (c.z + c.w)) + ((d.x + d.y) + (d.z + d.w));
    return 1.0f / sqrtf(s * (1.0f / DM) + EPS);
}
#define EPI_ARGS const f32x4 (&acc)[2][2][4][2], const pg8::Unit& u, int wr, int wc, int fr, int fq, int wid, int lane
DI float gamma_log2(int h) { return log2f(1.0f - exp2f(-5.0f - (float)h)); }
DI void unit_rnorm(LAS float* RN, const float* ssq, int arow) {
    const int t = threadIdx.x;
    if (t < 256) { int row = arow + t; row = row < RT ? row : RT - 1; RN[t] = row_rnorm(ssq, row); }
    asm volatile("s_waitcnt lgkmcnt(0)" ::: "memory"); __builtin_amdgcn_s_barrier(); asm volatile("" ::: "memory");
}

struct EpiG0 {
    bf16_t *CAT, *AQ, *AK, *AV, *IQ, *IK, *BQ, *BKZ, *BV; float* IW; const float* ssq; const f32x2* rot; LAS float* RN;
    DI void operator()(EPI_ARGS) const {
        const int pn = u.pn;
        unit_rnorm(RN, ssq, u.arow);
        float rs[2][4];
#pragma unroll
        for (int ai = 0; ai < 2; ++ai)
#pragma unroll
            for (int m = 0; m < 4; ++m) rs[ai][m] = RN[128 * ai + 64 * wr + 16 * m + fr];
        if (pn < 8 || pn >= 13) {
            bf16_t* base; int pitch, col0; float sc = 1.f;
            if (pn < 2) { base = AQ; pitch = 512; col0 = 256 * pn; sc = C2; }
            else if (pn < 4) { base = AK; pitch = 512; col0 = 256 * (pn - 2); }
            else if (pn < 6) { base = AV; pitch = 512; col0 = 256 * (pn - 4); }
            else if (pn < 8) { base = IQ; pitch = 512; col0 = 256 * (pn - 6); sc = 0.125f; }
            else if (pn < 17) { base = BV; pitch = 1024; col0 = 256 * (pn - 13); }
            else { base = CAT; pitch = 1536; col0 = 512 + 256 * (pn - 17); }
            col0 += 32 * wc + 8 * fq;
#pragma unroll
            for (int ai = 0; ai < 2; ++ai)
#pragma unroll
                for (int m = 0; m < 4; ++m) { const int row = u.arow + 128 * ai + 64 * wr + 16 * m + fr; const float s = rs[ai][m] * sc; bf16_t* rp = base + (size_t)row * pitch + col0;
#pragma unroll
                    for (int bj = 0; bj < 2; ++bj) { const f32x4 v0 = acc[ai][bj][m][0] * s, v1 = acc[ai][bj][m][1] * s;
                        u32x4 w; w.x = cvt_pk_bf16(v0[0], v0[1]); w.y = cvt_pk_bf16(v0[2], v0[3]); w.z = cvt_pk_bf16(v1[0], v1[1]); w.w = cvt_pk_bf16(v1[2], v1[3]);
                        *(u32x4*)(rp + bj * 128) = w; } }
        } else if (pn == 8) {
#pragma unroll
            for (int ai = 0; ai < 2; ++ai)
#pragma unroll
                for (int m = 0; m < 4; ++m) { const int row = u.arow + 128 * ai + 64 * wr + 16 * m + fr; const float s = rs[ai][m];
                    if (wc < 2) { const f32x4 v0 = acc[ai][0][m][0] * s, v1 = acc[ai][0][m][1] * s;
                        u32x4 w; w.x = cvt_pk_bf16(v0[0], v0[1]); w.y = cvt_pk_bf16(v0[2], v0[3]); w.z = cvt_pk_bf16(v1[0], v1[1]); w.w = cvt_pk_bf16(v1[2], v1[3]);
                        *(u32x4*)(IK + (size_t)row * 64 + 32 * wc + 8 * fq) = w; }
                    else if (wc == 2 && fq == 0) { const float s2 = s * 0.35355339059327373f; *(f32x4*)(IW + (size_t)row * 8) = acc[ai][0][m][0] * s2; *(f32x4*)(IW + (size_t)row * 8 + 4) = acc[ai][0][m][1] * s2; } }
        } else {
            const bool isk = pn >= 11; const int t = isk ? pn - 11 : pn - 9, head = 2 * t + (wc >> 1), i0 = 32 * (wc & 1) + 8 * fq;
            bf16_t* base = isk ? BKZ : BQ; const float lg = gamma_log2(head);
#pragma unroll
            for (int ai = 0; ai < 2; ++ai)
#pragma unroll
                for (int m = 0; m < 4; ++m) { const int row = u.arow + 128 * ai + 64 * wr + 16 * m + fr;
                    int pos = row < ROW0 ? row - MROW : 16 + ((row - ROW0) & (SEQ - 1)); pos = pos < 0 ? 0 : pos;
                    float s = rs[ai][m]; if (isk) s *= 0.08838834764831845f * exp2f((float)(127 - (row & 127)) * lg);
                    const f32x4* rp = (const f32x4*)(rot + (size_t)pos * 64 + i0); const f32x4 r0 = rp[0], r1 = rp[1], r2 = rp[2], r3 = rp[3];
                    const float cs[8] = {r0[0], r0[2], r1[0], r1[2], r2[0], r2[2], r3[0], r3[2]}, sn[8] = {r0[1], r0[3], r1[1], r1[3], r2[1], r2[3], r3[1], r3[3]};
                    float o1[8], o2[8];
#pragma unroll
                    for (int n = 0; n < 2; ++n)
#pragma unroll
                        for (int j = 0; j < 4; ++j) { const float x1 = acc[ai][0][m][n][j] * s, x2 = acc[ai][1][m][n][j] * s; o1[4 * n + j] = x1 * cs[4 * n + j] - x2 * sn[4 * n + j]; o2[4 * n + j] = x2 * cs[4 * n + j] + x1 * sn[4 * n + j]; }
                    u32x4 w1, w2; w1.x = cvt_pk_bf16(o1[0], o1[1]); w1.y = cvt_pk_bf16(o1[2], o1[3]); w1.z = cvt_pk_bf16(o1[4], o1[5]); w1.w = cvt_pk_bf16(o1[6], o1[7]);
                    w2.x = cvt_pk_bf16(o2[0], o2[1]); w2.y = cvt_pk_bf16(o2[2], o2[3]); w2.z = cvt_pk_bf16(o2[4], o2[5]); w2.w = cvt_pk_bf16(o2[6], o2[7]);
                    bf16_t* op = base + (size_t)row * 512 + 128 * head + i0; *(u32x4*)op = w1; *(u32x4*)(op + 64) = w2; }
        }
    }
};

template <bool FIRST>
struct EpiResid {
    Params P; bf16_t* HB; float* ssq;
    DI void operator()(EPI_ARGS) const {
        const int colb = 256 * u.pn + 32 * wc + 8 * fq;
#pragma unroll
        for (int ai = 0; ai < 2; ++ai)
#pragma unroll
            for (int m = 0; m < 4; ++m) { const int row = u.arow + 128 * ai + 64 * wr + 16 * m + fr; float sq = 0.f;
#pragma unroll
                for (int bj = 0; bj < 2; ++bj) { const int col = colb + 128 * bj;
                    f32x4 b0, b1;
                    if (FIRST) { const float* bp = P.x + (size_t)(row - ROW0) * DM + col; b0 = *(const f32x4*)bp; b1 = *(const f32x4*)(bp + 4); }
                    else { const u32x4 hb = *(const u32x4*)(HB + (size_t)row * DM + col);
                        b0 = (f32x4){__uint_as_float(hb.x << 16), __uint_as_float(hb.x & 0xffff0000u), __uint_as_float(hb.y << 16), __uint_as_float(hb.y & 0xffff0000u)};
                        b1 = (f32x4){__uint_as_float(hb.z << 16), __uint_as_float(hb.z & 0xffff0000u), __uint_as_float(hb.w << 16), __uint_as_float(hb.w & 0xffff0000u)}; }
                    const f32x4 v0 = b0 + acc[ai][bj][m][0], v1 = b1 + acc[ai][bj][m][1];
                    u32x4 w; w.x = cvt_pk_bf16(v0[0], v0[1]); w.y = cvt_pk_bf16(v0[2], v0[3]); w.z = cvt_pk_bf16(v1[0], v1[1]); w.w = cvt_pk_bf16(v1[2], v1[3]);
                    *(u32x4*)(HB + (size_t)row * DM + col) = w;
                    sq += (v0[0] * v0[0] + v0[1] * v0[1]) + (v0[2] * v0[2] + v0[3] * v0[3]) + (v1[0] * v1[0] + v1[1] * v1[1]) + (v1[2] * v1[2] + v1[3] * v1[3]); }
                sq += __shfl_xor(sq, 16); sq += __shfl_xor(sq, 32);
                if (fq == 0) ssq[(size_t)row * 16 + 4 * u.pn + wc] = sq; }
    }
};

struct EpiQKV1 {
    bf16_t *Q1, *K1, *V1; const float* ssq; LAS float* RN;
    DI void operator()(EPI_ARGS) const {
        unit_rnorm(RN, ssq, u.arow);
        const int pn = u.pn; bf16_t* base = Q1 + (size_t)(pn >> 2) * ((WS_K1 - WS_Q1) / 2);     const float sc = pn < 4 ? 0.125f : 1.f; const int col0 = 256 * (pn & 3) + 32 * wc + 8 * fq;
#pragma unroll
        for (int ai = 0; ai < 2; ++ai)
#pragma unroll
            for (int m = 0; m < 4; ++m) { const int row = u.arow + 128 * ai + 64 * wr + 16 * m + fr; const float s = RN[128 * ai + 64 * wr + 16 * m + fr] * sc; bf16_t* rp = base + (size_t)row * DM + col0;
#pragma unroll
                for (int bj = 0; bj < 2; ++bj) { const f32x4 v0 = acc[ai][bj][m][0] * s, v1 = acc[ai][bj][m][1] * s;
                    u32x4 w; w.x = cvt_pk_bf16(v0[0], v0[1]); w.y = cvt_pk_bf16(v0[2], v0[3]); w.z = cvt_pk_bf16(v1[0], v1[1]); w.w = cvt_pk_bf16(v1[2], v1[3]);
                    *(u32x4*)(rp + bj * 128) = w; } }
    }
};

DI float ror16(float v, int k, int lane) { return __shfl(v, (lane & 48) | ((lane - k) & 15)); }
struct EpiFfn {
    bf16_t* ACT; const float* ssq; const float* cw; const float* cb; LAS float* X; LAS float* RN;
    DI void operator()(EPI_ARGS) const {
        const int cl = 32 * wc + 8 * fq, cg = 128 * u.pn + cl;
        if (fr >= 14) {
#pragma unroll
            for (int ai = 0; ai < 2; ++ai) { LAS float* xp = X + ((ai * 2 + wr) * 2 + (fr - 14)) * 128 + cl;
                *(LAS f32x4*)xp = acc[ai][1][3][0]; *(LAS f32x4*)(xp + 4) = acc[ai][1][3][1]; }
        }
        unit_rnorm(RN, ssq, u.arow);
        float rs[2][4];
#pragma unroll
        for (int ai = 0; ai < 2; ++ai)
#pragma unroll
            for (int m = 0; m < 4; ++m) rs[ai][m] = RN[128 * ai + 64 * wr + 16 * m + fr];
        const int bidx = u.pm == 0 ? 0 : (u.pm - 1) / 17; const int rend = u.pm == 0 ? 256 : ROW0 + SEQ * (bidx + 1);
#pragma unroll
        for (int q = 0; q < 2; ++q) {
            const f32x4 w0 = *(const f32x4*)(cw + cg + 4 * q), w1 = *(const f32x4*)(cw + DFF + cg + 4 * q), w2 = *(const f32x4*)(cw + 2 * DFF + cg + 4 * q), bb = *(const f32x4*)(cb + cg + 4 * q);
#pragma unroll
            for (int ai = 0; ai < 2; ++ai) {
                f32x4 pv = {0.f, 0.f, 0.f, 0.f};
                const int g = ai * 2 + wr;
                if (g > 0 && fr >= 14) pv = *(const LAS f32x4*)(X + ((g - 1) * 2 + (fr - 14)) * 128 + cl + 4 * q) * RN[64 * (g - 1) + 48 + fr];
#pragma unroll
                for (int m = 0; m < 4; ++m) { const int rt = 128 * ai + 64 * wr + 16 * m + fr, row = u.arow + rt; const float s = rs[ai][m]; float o[4];
#pragma unroll
                    for (int j = 0; j < 4; ++j) { const float cur = acc[ai][1][m][q][j] * s; const float c1 = ror16(cur, 1, lane), c2 = ror16(cur, 2, lane), q1 = ror16(pv[j], 1, lane), q2 = ror16(pv[j], 2, lane);
                        const float p1 = fr >= 1 ? c1 : q1, p2 = fr >= 2 ? c2 : q2;
                        const float gc = w0[j] * p2 + w1[j] * p1 + w2[j] * cur + bb[j];
                        const float sg = __builtin_amdgcn_rcpf(1.0f + __builtin_amdgcn_exp2f(-gc * LOG2E));
                        o[j] = gc * sg * (acc[ai][0][m][q][j] * s); pv[j] = cur; }
                    const bool ok = (u.pm == 0 || rt >= 2) && row < rend;
                    if (ok) { u32x2 w; w.x = cvt_pk_bf16(o[0], o[1]); w.y = cvt_pk_bf16(o[2], o[3]); *(u32x2*)(ACT + (size_t)row * DFF + cg + 4 * q) = w; } }
            }
        }
    }
};
template <bool RESID, bool FIRST>
DI void skinny_job(LAS unsigned char* lds, const bf16_t* A, const bf16_t* Bt, int K, int job, const Params& P, float* H, bf16_t* HB, float* SSQ, bf16_t* Q1) {
    const int tid = opaque_tid(), lane = tid & 63, fr = lane & 15, fq = lane >> 4; const int wid = __builtin_amdgcn_readfirstlane(tid >> 6);
    const int t = wid & 3, kh = wid >> 2, kh0 = kh * (K >> 1);
    const bf16_t* ap = A + (size_t)(MROW + fr) * K + kh0 + fq * 8;
    const bf16_t* bp = Bt + (size_t)(64 * job + 16 * t + fr) * K + kh0 + fq * 8;
    f32x4 acc = {0.f, 0.f, 0.f, 0.f};
    const int nks = K >> 6;
#pragma unroll 4
    for (int ks = 0; ks < nks; ++ks) { const bf16x8 a = *(const bf16x8*)(ap + 32 * ks), b = *(const bf16x8*)(bp + 32 * ks); acc = __builtin_amdgcn_mfma_f32_16x16x32_bf16(b, a, acc, 0, 0, 0); }
    LAS f32x4* red = (LAS f32x4*)lds;
    LAS float* sqx = (LAS float*)(lds + 4096);
    if (kh == 1) red[t * 64 + lane] = acc;
    __syncthreads();
    const int row = MROW + fr, col = 64 * job + 16 * t + 4 * fq;
    if (kh == 0) {
        acc += red[t * 64 + lane];
        if (RESID) {
            f32x4 b0 = {0.f, 0.f, 0.f, 0.f};
            if (FIRST) b0 = *(const f32x4*)(P.meta + (size_t)fr * DM + col);
            else { const u32x2 hb = *(const u32x2*)(HB + (size_t)row * DM + col); b0 = (f32x4){__uint_as_float(hb.x << 16), __uint_as_float(hb.x & 0xffff0000u), __uint_as_float(hb.y << 16), __uint_as_float(hb.y & 0xffff0000u)}; }
            const f32x4 v = b0 + acc;
            u32x2 w; w.x = cvt_pk_bf16(v[0], v[1]); w.y = cvt_pk_bf16(v[2], v[3]); *(u32x2*)(HB + (size_t)row * DM + col) = w;
            float sq = (v[0] * v[0] + v[1] * v[1]) + (v[2] * v[2] + v[3] * v[3]);
            sq += __shfl_xor(sq, 16); sq += __shfl_xor(sq, 32);
            if (fq == 0) sqx[t * 16 + fr] = sq;
        } else {
            const float s = row_rnorm(SSQ, row) * (job < 16 ? 0.125f : 1.f);
            bf16_t* base = Q1 + (size_t)(job >> 4) * ((WS_K1 - WS_Q1) / 2);
            const f32x4 v = acc * s; u32x2 w; w.x = cvt_pk_bf16(v[0], v[1]); w.y = cvt_pk_bf16(v[2], v[3]);
            *(u32x2*)(base + (size_t)row * DM + (col & 1023)) = w;
        }
    }
    __syncthreads();
    if (RESID && tid < 16) SSQ[(size_t)(MROW + tid) * 16 + job] = (sqx[tid] + sqx[16 + tid]) + (sqx[32 + tid] + sqx[48 + tid]);
    __syncthreads();
}
namespace att {
constexpr int A_K = 0, A_V = 32768, A_WS = 65536, A_OST = 67584, A_TB = 100352, A_FLG = 100864;
DI int crow(int r, int hi) { return (r & 3) + 8 * (r >> 2) + 4 * hi; }
#define SBAR() __builtin_amdgcn_sched_barrier(0)
#define MFMA32(a, b, c) __builtin_amdgcn_mfma_f32_32x32x16_bf16((a), (b), (c), 0, 0, 0)

DI void pv(f32x16* o, int vb, bf16x8 pa0, bf16x8 pa1, bf16x8 pa2, bf16x8 pa3) {
#pragma unroll
    for (int d0 = 0; d0 < 2; ++d0) { s16x4 lo[4], hi[4];
#pragma unroll
        for (int ks = 0; ks < 4; ++ks) {
            asm volatile("ds_read_b64_tr_b16 %0,%1 offset:%c2" : "=&v"(lo[ks]) : "v"(vb), "i"(d0 * 4096 + ks * 1024) : "memory");
            asm volatile("ds_read_b64_tr_b16 %0,%1 offset:%c2" : "=&v"(hi[ks]) : "v"(vb), "i"(d0 * 4096 + ks * 1024 + 512) : "memory"); }
        asm volatile("s_waitcnt lgkmcnt(0)" ::: "memory"); SBAR();
#define PK(k) (bf16x8){lo[k][0], lo[k][1], lo[k][2], lo[k][3], hi[k][0], hi[k][1], hi[k][2], hi[k][3]}
        o[d0] = MFMA32(pa0, PK(0), o[d0]); o[d0] = MFMA32(pa1, PK(1), o[d0]); o[d0] = MFMA32(pa2, PK(2), o[d0]); o[d0] = MFMA32(pa3, PK(3), o[d0]);
#undef PK
    }
}
DI bf16x8 pack8(const f32x16& p, int b) { u32x4 w; w.x = cvt_pk_bf16(p[b], p[b + 1]); w.y = cvt_pk_bf16(p[b + 2], p[b + 3]); w.z = cvt_pk_bf16(p[b + 4], p[b + 5]); w.w = cvt_pk_bf16(p[b + 6], p[b + 7]); return __builtin_bit_cast(bf16x8, w); }

DI int t5_bucket(int n) {
    if (n < 16) return n;
    int b = 16; const int th[15] = {19, 21, 24, 27, 31, 35, 40, 46, 52, 59, 67, 77, 87, 99, 113};
#pragma unroll
    for (int i = 0; i < 15; ++i) b += (n >= th[i]) ? 1 : 0;
    return b;
}

template <int KIND>
DI void attn_unit(LAS unsigned char* lds, const bf16_t* Q, int qp, const bf16_t* Kg, const bf16_t* Vg, int kvp, bf16_t* O, int op, int h, int b, int qb, const unsigned char* BM, const float* relb) {
    const int tid = opaque_tid(), lane = tid & 63, r32 = lane & 31, hi = lane >> 5; const int wid = __builtin_amdgcn_readfirstlane(tid >> 6);
    const int qrow0 = qb < 0 ? 0 : ROW0 + SEQ * b + 256 * qb;
    const int qrow = qrow0 + 32 * wid + r32;
    const int qposw = qb < 0 ? 32 * wid - MROW : 16 + 256 * qb + 32 * wid;
    const int qpos = qposw + r32;
    bf16x8 qr[4];
#pragma unroll
    for (int d0 = 0; d0 < 4; ++d0) qr[d0] = *(const bf16x8*)(Q + (size_t)qrow * qp + h * 64 + d0 * 16 + hi * 8);
    LAS float* TB = (LAS float*)(lds + A_TB);
    LAS float* wsf = (LAS float*)(lds + A_WS) + wid * 64;
    volatile LAS int* flg = (volatile LAS int*)(lds + A_FLG);
    if (KIND == 0) { if (tid < 128) TB[tid] = relb[t5_bucket(tid) * 8 + h] * LOG2E; }
    else { if (tid < 16) flg[tid] = 0; }
    const int nreal = qb < 0 ? 0 : 4 * (qb + 1);
    const int nt = nreal + 1;
#define TILE_RT(it) (KIND == 0 ? (it) - 1 : ((it) < nreal ? nreal - 1 - (it) : -1))
#define TILE_ROW0(rt) ((rt) < 0 ? 192 : ROW0 + SEQ * b + 64 * (rt))
    const bf16_t* kb_ = Kg + h * 64 + wid * 8 + (size_t)lane * kvp;
    const bf16_t* vb_ = Vg + h * 64 + (wid >> 2) * 32 + (lane & 3) * 8 + (size_t)(16 * (wid & 3) + (lane >> 2)) * kvp;
    u32x4 kreg[2], vreg[2];
#define LOAD_PAIR(pi_) do { _Pragma("unroll") for (int sb_ = 0; sb_ < 2; ++sb_) { int it_ = 2 * (pi_) + sb_; it_ = it_ < nt ? it_ : nt - 1; const int row0_ = TILE_ROW0(TILE_RT(it_)); \
        kreg[sb_] = *(const u32x4*)(kb_ + (size_t)row0_ * kvp); vreg[sb_] = *(const u32x4*)(vb_ + (size_t)row0_ * kvp); } } while (0)
    LOAD_PAIR(0);
    float mrun = -INFINITY, lsum = 0.f, carry = 0.f; bool wdone = false;
    f32x16 o[2]; o[0] = f32x16{}; o[1] = f32x16{};
    const unsigned ldsb = (unsigned)(size_t)lds;
    const int vlane = ((lane >> 4) & 1) * 32 + (lane & 3) * 8 + (4 * hi + ((lane & 15) >> 2)) * 64;
    const int npair = (nt + 1) >> 1;
    for (int pi = 0; pi < npair; ++pi) {
#pragma unroll
        for (int sb = 0; sb < 2; ++sb) {
            *(LAS u32x4*)(lds + A_K + (pi & 1) * 16384 + sb * 8192 + wid * 1024 + lane * 16) = kreg[sb];
            *(LAS u32x4*)(lds + A_V + (pi & 1) * 16384 + sb * 8192 + wid * 1024 + lane * 16) = vreg[sb]; }
        __syncthreads();
        if (KIND == 1 && pi > 0) { int all = 1;
#pragma unroll
            for (int w = 0; w < 8; ++w) all &= flg[((pi - 1) & 1) * 8 + w];
            if (all) break; }
        if (pi + 1 < npair) LOAD_PAIR(pi + 1);
#pragma unroll
      for (int sb = 0; sb < 2; ++sb) {
        const int it = 2 * pi + sb; if (it >= nt) break;
        const int slot = (pi & 1) * 2 + sb;
        const int rt = TILE_RT(it);
        const int kpos0 = rt < 0 ? -48 : 16 + 64 * rt;
        bool active = true;
        if (KIND == 1) active = !wdone && (kpos0 < qposw + 31);
        unsigned wlo = 0u, whi = 0u;
        if (KIND == 0) {
            if (rt >= 0) { const u32x2 w = *(const u32x2*)(BM + (size_t)(SEQ * b + 256 * qb + 32 * wid + r32) * 512 + 8 * rt); wlo = w.x; whi = w.y; }
            else { const int top = qpos < 15 ? qpos : 15; whi = top < 0 ? 0u : (((2u << top) - 1u) << 16); }
        }
        if (active) {
            f32x16 p0 = f32x16{}, p1 = f32x16{};
            { const LAS unsigned char* kb = lds + A_K + slot * 8192 + hi * 1024 + r32 * 16;
#pragma unroll
              for (int d0 = 0; d0 < 4; ++d0) { const bf16x8 b0 = *(const LAS bf16x8*)(kb + d0 * 2048), b1 = *(const LAS bf16x8*)(kb + d0 * 2048 + 512);
                  p0 = MFMA32(b0, qr[d0], p0); p1 = MFMA32(b1, qr[d0], p1); } }
            if (KIND == 0) {
                if (qposw - (kpos0 + 63) >= 127) { const float c = TB[127];
#pragma unroll
                    for (int r = 0; r < 16; ++r) { p0[r] += c; p1[r] += c; } }
                else {
#pragma unroll
                    for (int r = 0; r < 16; ++r) { int rel = qpos - (kpos0 + crow(r, hi)); int i0 = rel < 0 ? 0 : (rel > 127 ? 127 : rel); rel -= 32; int i1 = rel < 0 ? 0 : (rel > 127 ? 127 : rel);
                        p0[r] += TB[i0]; p1[r] += TB[i1]; } }
                const unsigned ml = wlo >> (4 * hi), mh = whi >> (4 * hi);
#pragma unroll
                for (int r = 0; r < 16; ++r) { const unsigned bit = 1u << ((r & 3) + 8 * (r >> 2)); p0[r] = (ml & bit) ? p0[r] : -INFINITY; p1[r] = (mh & bit) ? p1[r] : -INFINITY; }
                float mx = -INFINITY;
#pragma unroll
                for (int r = 0; r < 16; ++r) mx = fmaxf(mx, fmaxf(p0[r], p1[r]));
                mx = fmaxf(mx, __shfl_xor(mx, 32));
                const float mnew = fmaxf(mrun, mx), msafe = (mnew == -INFINITY) ? 0.f : mnew;
                const float alpha = __builtin_amdgcn_exp2f(mrun - msafe);
                mrun = mnew;
                float ps = 0.f;
#pragma unroll
                for (int r = 0; r < 16; ++r) { p0[r] = __builtin_amdgcn_exp2f(p0[r] - msafe); p1[r] = __builtin_amdgcn_exp2f(p1[r] - msafe); ps += p0[r] + p1[r]; }
                lsum = lsum * alpha + ps;
                if (hi == 0) wsf[r32] = alpha;
                LDS_WAIT(); asm volatile("" ::: "memory");
#pragma unroll
                for (int r = 0; r < 16; ++r) { const float a = wsf[crow(r, hi)]; o[0][r] *= a; o[1][r] *= a; }
            } else {
                float L0[16], L1[16];
#pragma unroll
                for (int r = 0; r < 16; ++r) {
                    const int k0 = kpos0 + crow(r, hi), k1 = k0 + 32;
                    { const float z = p0[r], sp = fmaxf(z, 0.f) + LN2 * __builtin_amdgcn_logf(1.0f + __builtin_amdgcn_exp2f(-fabsf(z) * LOG2E)); const bool v = (k0 < qpos) && (k0 >= 0); L0[r] = v ? -sp : 0.f; p0[r] = v ? z - sp : -INFINITY; }
                    { const float z = p1[r], sp = fmaxf(z, 0.f) + LN2 * __builtin_amdgcn_logf(1.0f + __builtin_amdgcn_exp2f(-fabsf(z) * LOG2E)); const bool v = (k1 < qpos) && (k1 >= 0); L1[r] = v ? -sp : 0.f; p1[r] = v ? z - sp : -INFINITY; }
                }
                float g0[4], g1[4], og0[4], og1[4];
#pragma unroll
                for (int i = 0; i < 4; ++i) { g0[i] = (L0[4 * i] + L0[4 * i + 1]) + (L0[4 * i + 2] + L0[4 * i + 3]); g1[i] = (L1[4 * i] + L1[4 * i + 1]) + (L1[4 * i + 2] + L1[4 * i + 3]); og0[i] = __shfl_xor(g0[i], 32); og1[i] = __shfl_xor(g1[i], 32); }
                float sg1[4], sg0[4]; float run = 0.f;
#pragma unroll
                for (int i = 3; i >= 0; --i) { sg1[i] = run + (hi == 0 ? og1[i] : 0.f); run += g1[i] + og1[i]; }
#pragma unroll
                for (int i = 3; i >= 0; --i) { sg0[i] = run + (hi == 0 ? og0[i] : 0.f); run += g0[i] + og0[i]; }
#pragma unroll
                for (int i = 0; i < 4; ++i) {
                    float e = carry + sg0[i];
#pragma unroll
                    for (int j = 3; j >= 0; --j) { p0[4 * i + j] = __builtin_amdgcn_exp2f((p0[4 * i + j] + e) * LOG2E); e += L0[4 * i + j]; }
                    e = carry + sg1[i];
#pragma unroll
                    for (int j = 3; j >= 0; --j) { p1[4 * i + j] = __builtin_amdgcn_exp2f((p1[4 * i + j] + e) * LOG2E); e += L1[4 * i + j]; }
                }
                carry += run;
                wdone = __all(carry < -104.0f);
            }
            const bf16x8 pa0 = pack8(p0, 0), pa1 = pack8(p0, 8), pa2 = pack8(p1, 0), pa3 = pack8(p1, 8);
            SBAR();
            pv(o, (int)(ldsb + A_V + slot * 8192) + vlane, pa0, pa1, pa2, pa3);
        }
      }
        if (KIND == 1 && lane == 0) flg[(pi & 1) * 8 + wid] = wdone ? 1 : 0;
    }
#undef LOAD_PAIR
    float rli[16];
    if (KIND == 0) {
        lsum += __shfl_xor(lsum, 32);
        if (hi == 0) wsf[32 + r32] = lsum;
        LDS_WAIT(); asm volatile("" ::: "memory");
#pragma unroll
        for (int r = 0; r < 16; ++r) { const float l = wsf[32 + crow(r, hi)]; rli[r] = l > 0.f ? __builtin_amdgcn_rcpf(l) : 0.f; }
    } else {
#pragma unroll
        for (int r = 0; r < 16; ++r) rli[r] = 1.f;
    }
    { LAS bf16_t* stg = (LAS bf16_t*)(lds + A_OST) + wid * 2048;
#pragma unroll
      for (int r = 0; r < 16; ++r) { const int orow = crow(r, hi);
#pragma unroll
          for (int d0 = 0; d0 < 2; ++d0) stg[orow * 64 + d0 * 32 + r32] = (bf16_t)(cvt_pk_bf16(o[d0][r] * rli[r], 0.f) & 0xffffu); }
      LDS_WAIT(); asm volatile("" ::: "memory");
      bf16_t* Ow = O + (size_t)(qrow0 + 32 * wid) * op + h * 64;
#pragma unroll
      for (int i = 0; i < 4; ++i) { const int row = i * 8 + (lane >> 3), ch = lane & 7; const u32x4 v = *(const LAS u32x4*)(stg + row * 64 + ch * 8); *(u32x4*)(Ow + (size_t)row * op + ch * 8) = v; } }
    __syncthreads();
#undef TILE_RT
#undef TILE_ROW0
}
}
DI size_t sc_row_off(int b, int t) { const int Q = t >> 8; return (size_t)b * SC_BATCH + (size_t)32768 * Q * (Q + 1) + (size_t)(t & 255) * 256 * (Q + 1); }
constexpr int IDX_STEPS = 1088;
DI void indexer_range(LAS unsigned char* lds, int s0, int s1, const bf16_t* IQ, const bf16_t* IK, const float* IW, unsigned short* SC) {
    const int tid = opaque_tid(), lane = tid & 63, r32 = lane & 31, hi = lane >> 5; const int wid = __builtin_amdgcn_readfirstlane(tid >> 6);
    LAS float* wl = (LAS float*)(lds + 32768 + wid * 1024);
    const auto iqr = __builtin_amdgcn_make_buffer_rsrc((void*)IQ, 0, RT * 1024, 0x00020000);
    const auto iwr = __builtin_amdgcn_make_buffer_rsrc((void*)IW, 0, RT * 32, 0x00020000);
    bf16x8 qf[8][4]; int cur_bq = -1;
    for (int s = s0; s < s1; ++s) {
        const int b = s / 272; const int r = s % 272; int qg = 0; while ((qg + 1) * (qg + 2) <= r) ++qg; const int kc = r - qg * (qg + 1);
        if (b * 16 + qg != cur_bq) { cur_bq = b * 16 + qg;
            const unsigned qoff = (unsigned)(r32 * 1024 + hi * 16); const int qs = (ROW0 + SEQ * b + 256 * qg + 32 * wid) * 1024;
#pragma unroll
            for (int h = 0; h < 8; ++h) {
#pragma unroll
                for (int k = 0; k < 4; ++k) qf[h][k] = *(const bf16x8*)((const char*)IQ + (size_t)qs + qoff + h * 128 + k * 32); }
            const f32x4 wv = *(const f32x4*)((const char*)IW + (size_t)(ROW0 + SEQ * b + 256 * qg + 32 * wid) * 32 + r32 * 32 + hi * 16);
#pragma unroll
            for (int j = 0; j < 4; ++j) wl[(4 * hi + j) * 32 + r32] = wv[j]; }
        __syncthreads();
#pragma unroll
        for (int i = 0; i < 2; ++i) { const int idx = tid + 512 * i, key = idx >> 3, part = idx & 7;
            *(LAS u32x4*)(lds + key * 128 + ((part ^ (key & 7)) * 16)) = *(const u32x4*)(IK + (size_t)(ROW0 + SEQ * b + 128 * kc + key) * 64 + part * 8); }
        __syncthreads();
        const int t = 256 * qg + 32 * wid + r32;
        unsigned short* scp = SC + sc_row_off(b, t) + 4 * hi;
#pragma unroll 1
        for (int tile = 0; tile < 4; ++tile) {
            const int kt = 4 * kc + tile;
            if (32 * kt > 256 * qg + 32 * wid + 31) break;
            bf16x8 kf[4];
#pragma unroll
            for (int k = 0; k < 4; ++k) kf[k] = *(const LAS bf16x8*)(lds + (32 * tile + r32) * 128 + (((2 * k + hi) ^ (r32 & 7)) * 16));
            f32x16 sc = f32x16{};
#pragma unroll
            for (int h = 0; h < 8; ++h) { f32x16 a = f32x16{};
#pragma unroll
                for (int k = 0; k < 4; ++k) a = __builtin_amdgcn_mfma_f32_32x32x16_bf16(kf[k], qf[h][k], a, 0, 0, 0);
                const float wh = wl[h * 32 + r32];
#pragma unroll
                for (int i = 0; i < 16; ++i) { const int ai = __builtin_bit_cast(int, a[i]); sc[i] += fmaxf(a[i], 0.f) * wh; (void)ai; } }
#pragma unroll
            for (int gq = 0; gq < 4; ++gq) { unsigned v[4];
#pragma unroll
                for (int j = 0; j < 4; ++j) { float f = sc[4 * gq + j] * 4096.0f + 32768.0f; f = fminf(fmaxf(f, 0.f), 65535.f); v[j] = (unsigned)__float2int_rn(f); }
                u32x2 o; o.x = v[0] | (v[1] << 16); o.y = v[2] | (v[3] << 16);
                *(u32x2*)(scp + 32 * kt + 8 * gq) = o; }
        }
    }
    __syncthreads();
}

constexpr int SEL_LDS_PER_WAVE = 8192 + 256;
DI void select_load(int b, int t, const unsigned short* SC, u32x4 (&raw)[8], int lane) {
    const unsigned short* row = SC + sc_row_off(b, t); const int pitch = 256 * ((t >> 8) + 1);
#pragma unroll
    for (int j = 0; j < 8; ++j) { const int k0 = (j * 64 + lane) * 8; raw[j] = (u32x4){0u, 0u, 0u, 0u}; if (t >= 240 && k0 < pitch && k0 <= t) raw[j] = *(const u32x4*)(row + k0); }
}
DI void select_row(int b, int t, const u32x4 (&raw)[8], unsigned char* BM, LAS unsigned* hist, int lane) {
    unsigned char* bm = BM + (size_t)(SEQ * b + t) * 512;
    const int n = t + 1;
    if (n <= 240) {
#pragma unroll
        for (int j = 0; j < 8; ++j) { const int k0 = (j * 64 + lane) * 8; int c = n - k0; c = c < 0 ? 0 : (c > 8 ? 8 : c); bm[j * 64 + lane] = (unsigned char)((1u << c) - 1u); }
        return;
    }
    unsigned key[8][8];
#pragma unroll
    for (int j = 0; j < 8; ++j)
#pragma unroll
        for (int e = 0; e < 4; ++e) { const int k = (j * 64 + lane) * 8 + 2 * e;
            key[j][2 * e] = (k <= t) ? (raw[j][e] & 0xffffu) : 0u; key[j][2 * e + 1] = (k + 1 <= t) ? (raw[j][e] >> 16) : 0u; }
    LAS unsigned* h2 = hist + 2048;
#pragma unroll
    for (int i = 0; i < 8; ++i) *(LAS u32x4*)(hist + (i * 64 + lane) * 4) = (u32x4){0u, 0u, 0u, 0u};
    if (lane < 16) h2[lane] = 0u;
    LDS_WAIT(); asm volatile("" ::: "memory");
#pragma unroll
    for (int j = 0; j < 8; ++j) { if ((j * 64 + lane) * 8 <= t) {
#pragma unroll
        for (int e = 0; e < 8; ++e) { const unsigned kv = key[j][e];
            __hip_atomic_fetch_add(&hist[kv >> 5], 1u << ((kv >> 4 & 1u) * 16), __ATOMIC_RELAXED, __HIP_MEMORY_SCOPE_WORKGROUP); } } }
    LDS_WAIT(); asm volatile("" ::: "memory");
    unsigned need = 240, thr;
    {
        unsigned s = 0;
#pragma unroll
        for (int i = 0; i < 8; ++i) { const u32x4 v = *(const LAS u32x4*)(hist + lane * 32 + i * 4); s += (v.x & 0xffffu) + (v.x >> 16) + (v.y & 0xffffu) + (v.y >> 16) + (v.z & 0xffffu) + (v.z >> 16) + (v.w & 0xffffu) + (v.w >> 16); }
        unsigned suf = s;
#pragma unroll
        for (int o = 1; o < 64; o <<= 1) { const unsigned v = __shfl_down(suf, o); if (lane + o < 64) suf += v; }
        const unsigned above = suf - s;
        const unsigned long long m = __ballot(above < need && suf >= need); const int L = (int)__builtin_ctzll(m ? m : 1ull);
        need -= __shfl(above, L);
        const unsigned dw = hist[L * 32 + (lane >> 1)]; const unsigned c = (lane & 1) ? (dw >> 16) : (dw & 0xffffu);
        unsigned suf2 = c;
#pragma unroll
        for (int o = 1; o < 64; o <<= 1) { const unsigned v = __shfl_down(suf2, o); if (lane + o < 64) suf2 += v; }
        const unsigned above2 = suf2 - c;
        const unsigned long long m2 = __ballot(above2 < need && suf2 >= need); const int I = (int)__builtin_ctzll(m2 ? m2 : 1ull);
        need -= __shfl(above2, I);
        const unsigned b12 = (unsigned)(64 * L + I);
#pragma unroll
        for (int j = 0; j < 8; ++j) { bool any = false;
#pragma unroll
            for (int e = 0; e < 8; ++e) any |= (key[j][e] >> 4) == b12;
            if (any) {
#pragma unroll
                for (int e = 0; e < 8; ++e) { const unsigned kv = key[j][e]; if ((kv >> 4) == b12) __hip_atomic_fetch_add(&h2[kv & 15u], 1u, __ATOMIC_RELAXED, __HIP_MEMORY_SCOPE_WORKGROUP); } } }
        LDS_WAIT(); asm volatile("" ::: "memory");
        const unsigned c3 = lane < 16 ? h2[lane] : 0u;
        unsigned suf3 = c3;
#pragma unroll
        for (int o = 1; o < 16; o <<= 1) { const unsigned v = __shfl_down(suf3, o); if (lane + o < 64) suf3 += v; }
        const unsigned above3 = suf3 - c3;
        const unsigned long long m3 = __ballot(lane < 16 && above3 < need && suf3 >= need); const int J = (int)__builtin_ctzll(m3 ? m3 : 1ull);
        need -= __shfl(above3, J);
        thr = (b12 << 4) | (unsigned)J;
        const unsigned ceq = __shfl(c3, J);
        if (ceq == need) need = 0xffffu;
    }
    if (need == 0xffffu) {
#pragma unroll
        for (int j = 0; j < 8; ++j) { unsigned bits = 0;
#pragma unroll
            for (int e = 0; e < 8; ++e) bits |= (key[j][e] >= thr) ? (1u << e) : 0u;
            int c = n - (j * 64 + lane) * 8; c = c < 0 ? 0 : (c > 8 ? 8 : c);
            bm[j * 64 + lane] = (unsigned char)(bits & ((1u << c) - 1u)); }
    } else {
        unsigned eqbase = 0;
#pragma unroll 1
        for (int j = 0; j < 8; ++j) {
            unsigned ce = 0;
#pragma unroll
            for (int e = 0; e < 8; ++e) { const int k = (j * 64 + lane) * 8 + e; unsigned kv = 0;
#pragma unroll
                for (int jj = 0; jj < 8; ++jj) kv = (jj == j) ? key[jj][e] : kv;
                ce += (k <= t && kv == thr) ? 1u : 0u; }
            unsigned inc = ce;
#pragma unroll
            for (int o = 1; o < 64; o <<= 1) { const unsigned v = __shfl_up(inc, o); if (lane >= o) inc += v; }
            unsigned rank = eqbase + inc - ce;
            eqbase += __shfl(inc, 63);
            unsigned bits = 0;
#pragma unroll
            for (int e = 0; e < 8; ++e) { const int k = (j * 64 + lane) * 8 + e; unsigned kv = 0;
#pragma unroll
                for (int jj = 0; jj < 8; ++jj) kv = (jj == j) ? key[jj][e] : kv;
                bool sel = false;
                if (k <= t) { if (kv > thr) sel = true; else if (kv == thr) { sel = rank < need; ++rank; } }
                bits |= sel ? (1u << e) : 0u; }
            bm[j * 64 + lane] = (unsigned char)bits;
        }
    }
    LDS_WAIT(); asm volatile("" ::: "memory");
}

constexpr int RL_K = 0, RL_V = 32768;
DI void kv_tile_unit(LAS unsigned char* lds, int b, int h, int cc, const bf16_t* BKZ, const bf16_t* BV, bf16_t* RS) {
    const int tid = opaque_tid(), lane = tid & 63, hi = lane >> 5, r32 = lane & 31; const int wid = __builtin_amdgcn_readfirstlane(tid >> 6);
    const int db = wid & 3, fh = wid >> 2;
    const int row0 = cc < 0 ? 128 : ROW0 + SEQ * b + 128 * cc;
#pragma unroll
    for (int i = 0; i < 4; ++i) { const int idx = tid + 512 * i, piece = idx >> 6, l = idx & 63; const int e = 16 * (piece & 7) + (l >> 2), d = 32 * (piece >> 3) + 8 * (l & 3);
        *(LAS u32x4*)(lds + RL_K + idx * 16) = *(const u32x4*)(BKZ + (size_t)(row0 + e) * 512 + 128 * h + d); }
#pragma unroll
    for (int i = 0; i < 8; ++i) { const int idx = tid + 512 * i, piece = idx >> 6, l = idx & 63; const int e = 16 * (piece & 7) + (l >> 2), f = 32 * (piece >> 3) + 8 * (l & 3);
        *(LAS u32x4*)(lds + RL_V + idx * 16) = *(const u32x4*)(BV + (size_t)(row0 + e) * 1024 + 256 * h + f); }
    __syncthreads();
    const unsigned ldsb = (unsigned)(size_t)lds;
    const int vlane = ((lane >> 4) & 1) * 32 + (lane & 3) * 8 + (4 * hi + ((lane & 15) >> 2)) * 64;
    f32x16 kv[4];
#pragma unroll
    for (int fb = 0; fb < 4; ++fb) kv[fb] = f32x16{};
#pragma unroll
    for (int ks = 0; ks < 8; ++ks) { s16x4 al, ah, bl[4], bh[4];
        const int ka = (int)ldsb + RL_K + (db * 8 + ks) * 1024 + vlane, va = (int)ldsb + RL_V + (4 * fh * 8 + ks) * 1024 + vlane;
        asm volatile("ds_read_b64_tr_b16 %0,%1" : "=&v"(al) : "v"(ka) : "memory");
        asm volatile("ds_read_b64_tr_b16 %0,%1 offset:512" : "=&v"(ah) : "v"(ka) : "memory");
#pragma unroll
        for (int fb = 0; fb < 4; ++fb) {
            asm volatile("ds_read_b64_tr_b16 %0,%1 offset:%c2" : "=&v"(bl[fb]) : "v"(va), "i"(fb * 8192) : "memory");
            asm volatile("ds_read_b64_tr_b16 %0,%1 offset:%c2" : "=&v"(bh[fb]) : "v"(va), "i"(fb * 8192 + 512) : "memory"); }
        asm volatile("s_waitcnt lgkmcnt(0)" ::: "memory"); __builtin_amdgcn_sched_barrier(0);
        const bf16x8 A = {al[0], al[1], al[2], al[3], ah[0], ah[1], ah[2], ah[3]};
#pragma unroll
        for (int fb = 0; fb < 4; ++fb) { const bf16x8 B = {bl[fb][0], bl[fb][1], bl[fb][2], bl[fb][3], bh[fb][0], bh[fb][1], bh[fb][2], bh[fb][3]};
            kv[fb] = __builtin_amdgcn_mfma_f32_32x32x16_bf16(A, B, kv[fb], 0, 0, 0); } }
#pragma unroll
    for (int fb = 0; fb < 4; ++fb) { bf16_t* rp = RS + ((((size_t)(b * 4 + h) * 32 + (cc + 1)) * 256) + 128 * fh + 32 * fb + r32) * 128 + 32 * db + 4 * hi;
#pragma unroll
        for (int gq = 0; gq < 4; ++gq) { u32x2 o; o.x = cvt_pk_bf16(kv[fb][4 * gq], kv[fb][4 * gq + 1]); o.y = cvt_pk_bf16(kv[fb][4 * gq + 2], kv[fb][4 * gq + 3]); *(u32x2*)(rp + 8 * gq) = o; } }
    __syncthreads();
}
DI void ret_scan(int chain, bf16_t* RS) {
    const int bh = chain >> 13, eg = chain & 8191; const float g = exp2f(128.0f * gamma_log2(bh & 3));
    u32x2* p = (u32x2*)(RS + (size_t)bh * 32 * 32768 + (size_t)eg * 4);
    u32x2 v[32];
#pragma unroll
    for (int s = 0; s < 32; ++s) v[s] = p[(size_t)s * 8192];
    float s0 = 0.f, s1 = 0.f, s2 = 0.f, s3 = 0.f;
#pragma unroll
    for (int s = 0; s < 32; ++s) {
        s0 = s0 * g + __uint_as_float(v[s].x << 16); s1 = s1 * g + __uint_as_float(v[s].x & 0xffff0000u); s2 = s2 * g + __uint_as_float(v[s].y << 16); s3 = s3 * g + __uint_as_float(v[s].y & 0xffff0000u);
        u32x2 o; o.x = cvt_pk_bf16(s0, s1); o.y = cvt_pk_bf16(s2, s3); p[(size_t)s * 8192] = o; }
}

constexpr int RO_K = 0, RO_V = 32768, RO_X = 98304;
DI void ret_out_unit(LAS unsigned char* lds, int b, int h, int c, const bf16_t* BQ, const bf16_t* BKZ, const bf16_t* BV, const bf16_t* RS, bf16_t* CAT, const float* gng) {
    const int tid = opaque_tid(), lane = tid & 63, hi = lane >> 5, r32 = lane & 31; const int wid = __builtin_amdgcn_readfirstlane(tid >> 6);
    const int rb = wid & 3, fh = wid >> 2;
    const int row0 = c < 0 ? 128 : ROW0 + SEQ * b + 128 * c;
    const float lg = gamma_log2(h);
#pragma unroll 1
    for (int i = 0; i < 4; ++i) { const int idx = tid + 512 * i, et = idx >> 10, rem = idx & 1023, dc = rem >> 6, e = rem & 63;
        *(LAS u32x4*)(lds + RO_K + et * 16384 + dc * 1024 + e * 16) = *(const u32x4*)(BKZ + (size_t)(row0 + 64 * et + e) * 512 + 128 * h + 8 * dc); }
    asm volatile("" ::: "memory");
#pragma unroll 2
    for (int i = 0; i < 8; ++i) { const int idx = tid + 512 * i, et = idx >> 11, rem = idx & 2047, piece = rem >> 6, l = rem & 63; const int e = 16 * (piece & 3) + (l >> 2), f = 32 * (piece >> 2) + 8 * (l & 3);
        *(LAS u32x4*)(lds + RO_V + et * 32768 + piece * 1024 + l * 16) = *(const u32x4*)(BV + (size_t)(row0 + 64 * et + e) * 1024 + 256 * h + f); if (i == 3) asm volatile("" ::: "memory"); }
    asm volatile("" ::: "memory");
    bf16x8 qf[8];
#pragma unroll
    for (int s = 0; s < 8; ++s) qf[s] = *(const bf16x8*)(BQ + (size_t)(row0 + 32 * rb + r32) * 512 + 128 * h + 16 * s + 8 * hi);
    f32x16 o[4];
#pragma unroll
    for (int fb = 0; fb < 4; ++fb) o[fb] = f32x16{};
    if (c >= 0) {
        const bf16_t* rs = RS + (((size_t)(b * 4 + h) * 32 + c) * 256 + 128 * fh + r32) * 128 + 8 * hi;
#pragma unroll
        for (int fb = 0; fb < 4; ++fb) {
#pragma unroll
            for (int s = 0; s < 8; ++s) { const bf16x8 rf = *(const bf16x8*)(rs + (size_t)(32 * fb) * 128 + 16 * s); o[fb] = __builtin_amdgcn_mfma_f32_32x32x16_bf16(qf[s], rf, o[fb], 0, 0, 0); }
            asm volatile("" ::: "memory"); }
#pragma unroll
        for (int r = 0; r < 16; ++r) { const float xi = exp2f((float)(32 * rb + att::crow(r, hi) + 1) * lg);
#pragma unroll
            for (int fb = 0; fb < 4; ++fb) o[fb][r] *= xi; }
    }
    __syncthreads();
    const unsigned ldsb = (unsigned)(size_t)lds;
    const int vlane = ((lane >> 4) & 1) * 32 + (lane & 3) * 8 + (4 * hi + ((lane & 15) >> 2)) * 64;
    const int n = 32 * rb + r32;
    const float rowfac = exp2f((float)(n - 127) * lg);
    const int net = rb >= 2 ? 2 : 1;
    for (int et = 0; et < net; ++et) {
        f32x16 p0 = f32x16{}, p1 = f32x16{};
        const LAS unsigned char* kb = lds + RO_K + et * 16384 + hi * 1024 + r32 * 16;
#pragma unroll
        for (int s = 0; s < 8; ++s) { const bf16x8 b0 = *(const LAS bf16x8*)(kb + s * 2048), b1 = *(const LAS bf16x8*)(kb + s * 2048 + 512);
            p0 = __builtin_amdgcn_mfma_f32_32x32x16_bf16(b0, qf[s], p0, 0, 0, 0); p1 = __builtin_amdgcn_mfma_f32_32x32x16_bf16(b1, qf[s], p1, 0, 0, 0); }
#pragma unroll
        for (int r = 0; r < 16; ++r) { const int e0 = 64 * et + att::crow(r, hi); p0[r] = (e0 <= n) ? p0[r] * rowfac : 0.f; p1[r] = (e0 + 32 <= n) ? p1[r] * rowfac : 0.f; }
        const bf16x8 pa[4] = {att::pack8(p0, 0), att::pack8(p0, 8), att::pack8(p1, 0), att::pack8(p1, 8)};
        __builtin_amdgcn_sched_barrier(0);
#pragma unroll
        for (int fb = 0; fb < 4; ++fb) { s16x4 lo[4], hh[4];
            const int va = (int)ldsb + RO_V + et * 32768 + ((4 * fh + fb) * 4) * 1024 + vlane;
#pragma unroll
            for (int ks = 0; ks < 4; ++ks) {
                asm volatile("ds_read_b64_tr_b16 %0,%1 offset:%c2" : "=&v"(lo[ks]) : "v"(va), "i"(ks * 1024) : "memory");
                asm volatile("ds_read_b64_tr_b16 %0,%1 offset:%c2" : "=&v"(hh[ks]) : "v"(va), "i"(ks * 1024 + 512) : "memory"); }
            asm volatile("s_waitcnt lgkmcnt(0)" ::: "memory"); __builtin_amdgcn_sched_barrier(0);
#pragma unroll
            for (int ks = 0; ks < 4; ++ks) { const bf16x8 vf = {lo[ks][0], lo[ks][1], lo[ks][2], lo[ks][3], hh[ks][0], hh[ks][1], hh[ks][2], hh[ks][3]};
                o[fb] = __builtin_amdgcn_mfma_f32_32x32x16_bf16(pa[ks], vf, o[fb], 0, 0, 0); } }
    }
    LAS float* X = (LAS float*)(lds + RO_X);
#pragma unroll
    for (int r = 0; r < 16; ++r) { float a = 0.f, q = 0.f;
#pragma unroll
        for (int fb = 0; fb < 4; ++fb) { a += o[fb][r]; q += o[fb][r] * o[fb][r]; }
#pragma unroll
        for (int m = 1; m < 32; m <<= 1) { a += __shfl_xor(a, m); q += __shfl_xor(q, m); }
        if (r32 == 0) { LAS float* xp = X + (((rb * 2 + fh) * 32) + att::crow(r, hi)) * 2; xp[0] = a; xp[1] = q; } }
    __syncthreads();
    bf16_t* cat = CAT + (size_t)(row0 + 32 * rb) * 1536 + 512 + 256 * h + 128 * fh + r32;
#pragma unroll
    for (int r = 0; r < 16; ++r) { const int nr = att::crow(r, hi);
        const LAS float* xa = X + (((rb * 2 + 0) * 32) + nr) * 2; const LAS float* xb = X + (((rb * 2 + 1) * 32) + nr) * 2;
        const float sum = xa[0] + xb[0], sq = xa[1] + xb[1]; const float mu = sum * (1.0f / 256.0f); float var = sq * (1.0f / 256.0f) - mu * mu; var = var < 0.f ? 0.f : var;
        const float rstd = 1.0f / sqrtf(var + EPS);
#pragma unroll
        for (int fb = 0; fb < 4; ++fb) { bf16_t* p = cat + (size_t)nr * 1536 + 32 * fb; const float gate = bf2f(*p); const float sg = gate / (1.0f + __expf(-gate));
            const float v = (o[fb][r] - mu) * rstd * gng[256 * h + 128 * fh + 32 * fb + r32] * sg; *p = (bf16_t)(cvt_pk_bf16(v, 0.f) & 0xffffu); }
        asm volatile("" ::: "memory"); }
    __syncthreads();
}
#ifndef PH_LO
#define PH_LO 0
#endif
#ifndef PH_HI
#define PH_HI 15
#endif
__global__ void __launch_bounds__(NWAVES * 64, 2) fwd_kernel(Params P) {
    extern __shared__ __attribute__((aligned(16))) unsigned char lds_raw[];
    LAS unsigned char* lds = (LAS unsigned char*)lds_raw;
    volatile LAS unsigned* MISC = (volatile LAS unsigned*)(lds + MISC_OFF);
    const int G = gridDim.x; const int bx = blockIdx.x; const int vcu = (G % 8 == 0) ? (bx % 8) * (G / 8) + bx / 8 : bx;
    const int NGW = G * NWAVES;
#define PHASE_IDS() const int tid = opaque_tid(), lane = tid & 63, wave = __builtin_amdgcn_readfirstlane(tid >> 6), gw = vcu * NWAVES + wave; (void)lane; (void)gw
    gu32* ctl = (gu32*)(P.ws + WS_CTL);
    for (int u = threadIdx.x; u < (LDS_BYTES - LDSCTL_OFF) / 4; u += NWAVES * 64) ((LAS unsigned*)(lds + LDSCTL_OFF))[u] = 0u;
    __syncthreads();
    XcdBarrier bar = xcd_barrier_post((unsigned*)(ctl + CW_BAR), MISC + 8);

#define PTRS() unsigned char* ws = P.ws; unsigned char* dob = (unsigned char*)P.out; asm volatile("" : "+s"(ws), "+s"(dob)); \
    float* SSQ = (float*)(ws + WS_SSQ); float* H = (float*)(ws + WS_H); bf16_t* HB = (bf16_t*)(ws + WS_HB); \
    bf16_t* AQ = (bf16_t*)(ws + WS_AQ); bf16_t* O1 = (bf16_t*)(ws + WS_O1); bf16_t* AK = (bf16_t*)(ws + WS_AK); bf16_t* AV = (bf16_t*)(ws + WS_AV); bf16_t* IQ = (bf16_t*)(ws + WS_IQ); \
    unsigned short* SC = (unsigned short*)(ws + WS_SC); bf16_t* CAT = (bf16_t*)(ws + WS_CAT); \
    bf16_t* BQ = (bf16_t*)(ws + WS_BQ); bf16_t* BKZ = (bf16_t*)(ws + WS_BKZ); bf16_t* BV = (bf16_t*)(ws + WS_BV); \
    bf16_t* ACT = (bf16_t*)(ws + WS_BIG); bf16_t* Q1 = (bf16_t*)(ws + WS_Q1); bf16_t* K1 = (bf16_t*)(ws + WS_K1); bf16_t* V1 = (bf16_t*)(ws + WS_V1); \
    bf16_t* WIN0 = (bf16_t*)(dob + DO_WIN0); bf16_t* RS = (bf16_t*)(dob + DO_RS); \
    bf16_t* WOUT0 = (bf16_t*)(dob + DO_WOUT0); bf16_t* WUG0 = (bf16_t*)(dob + DO_WUG0); bf16_t* WDN0 = (bf16_t*)(dob + DO_WDN0); \
    bf16_t* WIN1 = (bf16_t*)(dob + DO_WIN1); bf16_t* WOUT1 = (bf16_t*)(dob + DO_WOUT1); bf16_t* WUG1 = (bf16_t*)(dob + DO_WUG1); bf16_t* WDN1 = (bf16_t*)(dob + DO_WDN1); \
    unsigned char* BM = dob + DO_BM; f32x2* ROT = (f32x2*)(dob + DO_ROT); bf16_t* IK = (bf16_t*)(dob + DO_IK); float* IW = (float*)(dob + DO_IW); \
    (void)SSQ; (void)H; (void)HB; (void)AQ; (void)O1; (void)AK; (void)AV; (void)IQ; (void)SC; (void)CAT; (void)BQ; (void)BKZ; (void)BV; (void)ACT; (void)Q1; (void)K1; (void)V1; (void)WIN0; (void)RS; (void)WOUT0; (void)WUG0; (void)WDN0; (void)WIN1; (void)WOUT1; (void)WUG1; (void)WDN1; (void)BM; (void)ROT; (void)IK; (void)IW

#define IN(k) (PH_LO <= (k) && (k) < PH_HI)
#ifndef REP_PHASE
#define REP_PHASE -1
#endif
#define REPS(k) for (int rep_ = 0; rep_ < ((k) == REP_PHASE ? 2 : 1); ++rep_, ((k) == REP_PHASE && rep_ == 1 ? xcd_barrier(bar) : (void)0))
#define SEAM(k) do { if (IN(k) && IN((k) + 1)) xcd_barrier(bar); } while (0)

    if (IN(0)) REPS(0) {
        PTRS();
        PHASE_IDS();
        LAS float* scr = (LAS float*)(lds + wave * 16384);
#ifdef REP_P0A
        for (int ra_ = 0; ra_ < 2; ++ra_)
#endif
        for (int it = gw; it < 16 * (N0 / 32); it += NGW) transpose_item<1>(P.win0, nullptr, 1024, N0, WIN0, P.nmix, scr, it, lane);
        for (int e = vcu * 512 + tid; e < 4112 * 64; e += G * 512) { const int pos = e >> 6, i = e & 63;
            const float inv = 1.0f / powf(10000.0f, (float)i * (1.0f / 64.0f)); const float ang = (float)pos * inv;
            const double rev = (double)ang * 0.15915494309189535; const float fr = (float)(rev - floor(rev));
            ROT[e] = (f32x2){__builtin_amdgcn_cosf(fr), __builtin_amdgcn_sinf(fr)}; }
#ifdef REP_P0B
        for (int rb_ = 0; rb_ < 2; ++rb_)
#endif
        for (int r = gw; r < RT; r += NGW) { const float* src = h0_row(P, r);
            f32x4 v[4]; float s = 0.f;
#pragma unroll
            for (int j = 0; j < 4; ++j) { v[j] = src ? ((const f32x4*)src)[lane + 64 * j] : (f32x4){0.f, 0.f, 0.f, 0.f}; s += (v[j][0] * v[j][0] + v[j][1] * v[j][1]) + (v[j][2] * v[j][2] + v[j][3] * v[j][3]); }
            s = wave_sum(s);
#pragma unroll
            for (int j = 0; j < 4; ++j) { u32x2 o; o.x = cvt_pk_bf16(v[j][0], v[j][1]); o.y = cvt_pk_bf16(v[j][2], v[j][3]); ((u32x2*)(HB + (size_t)r * DM))[lane + 64 * j] = o; }
            if (lane < 16) SSQ[(size_t)r * 16 + lane] = lane == 0 ? s : 0.f; }
    }
    SEAM(0);
    if (IN(1)) REPS(1) {
        PTRS();
        pg8::Gemm g{HB, WIN0, 1024}; pg8::SchedPlain S; S.init(NMT, N0 / 256, G, bx, 0);
        EpiG0 E{CAT, AQ, AK, AV, IQ, IK, BQ, BKZ, BV, IW, SSQ, ROT, (LAS float*)(lds + LDSX_OFF + 4096)};
        pg8::gemm_phase(lds, g, S, E);
    }
    SEAM(1);
    if (IN(2)) REPS(2) {
        PTRS();
        PHASE_IDS();
#ifdef REP_KV
        for (int rk_ = 0; rk_ < 2; ++rk_)
#endif
        for (int u = vcu; u < 512; u += G) kv_tile_unit(lds, u >> 7, (u >> 5) & 3, (u & 31) - 1, BKZ, BV, RS);
#ifdef REP_IDX
        for (int ri_ = 0; ri_ < 2; ++ri_)
#endif
        indexer_range(lds, (int)((long)IDX_STEPS * vcu / G), (int)((long)IDX_STEPS * (vcu + 1) / G), IQ, IK, IW, SC);
    }
    SEAM(2);
    if (IN(3)) REPS(3) {
        PTRS();
        PHASE_IDS();
        for (int c = vcu * 512 + tid; c < 16 * 8192; c += G * 512) ret_scan(c, RS);
        LAS unsigned* hist = (LAS unsigned*)(lds + wave * SEL_LDS_PER_WAVE);
#ifdef REP_SELECT
        for (int rs_ = 0; rs_ < 2; ++rs_)
#endif
        { u32x4 raw[8], nraw[8];
          if (gw < NB * SEQ) select_load(gw >> 12, gw & (SEQ - 1), SC, raw, lane);
          for (int r = gw; r < NB * SEQ; r += NGW) { const int rn = r + NGW;
              if (rn < NB * SEQ) select_load(rn >> 12, rn & (SEQ - 1), SC, nraw, lane);
              select_row(r >> 12, r & (SEQ - 1), raw, BM, hist, lane);
#pragma unroll
              for (int j = 0; j < 8; ++j) raw[j] = nraw[j]; } }
    }
    SEAM(3);
    if (IN(4)) REPS(4) {
        PTRS();
        PHASE_IDS();
        for (int u = vcu; u < 516; u += G) { const int ub = u < 512 ? u >> 7 : 0, uh = u < 512 ? (u >> 5) & 3 : u - 512, uc = u < 512 ? (u & 31) : -1; ret_out_unit(lds, ub, uh, uc, BQ, BKZ, BV, RS, CAT, P.gng); }
    }
    SEAM(4);
    if (IN(5)) REPS(5) {
        PTRS();
        PHASE_IDS();
        LAS float* scr = (LAS float*)(lds + wave * 16384);
        constexpr int I0 = 24 * 32, I1 = 16 * 176, I2 = 44 * 32, I3 = 16 * 96, I4 = 16 * 32;
        for (int it = gw; it < I0 + 2 * I1 + 2 * I2 + I3 + I4; it += NGW) { int r = it;
            if (r < I0) { transpose_item<0>(P.wout0, nullptr, 1536, 1024, WOUT0, nullptr, scr, r, lane); continue; } r -= I0;
            if (r < I1) { transpose_item<2>(P.wup, P.wgate, 1024, 5632, WUG0, P.nffn, scr, r, lane); continue; } r -= I1;
            if (r < I2) { transpose_item<0>(P.wdown, nullptr, DFF, 1024, WDN0, nullptr, scr, r, lane); continue; } r -= I2;
            if (r < I3) { transpose_item<0>(P.win1, nullptr, 1024, 3072, WIN1, P.nmix + DM, scr, r, lane); continue; } r -= I3;
            if (r < I4) { transpose_item<0>(P.wout1, nullptr, 1024, 1024, WOUT1, nullptr, scr, r, lane); continue; } r -= I4;
            if (r < I1) { transpose_item<2>(P.wup + (size_t)DM * DFF, P.wgate + (size_t)DM * DFF, 1024, 5632, WUG1, P.nffn + DM, scr, r, lane); continue; } r -= I1;
            transpose_item<0>(P.wdown + (size_t)DFF * DM, nullptr, DFF, 1024, WDN1, nullptr, scr, r, lane); }
        __syncthreads();
        for (int p = vcu; p < 256; p += G)
#pragma unroll 1
            for (int k = 0; k < 3; ++k) { if (k == 2 && p >= 8) break; const int u = k == 1 ? 511 - p : p; const int qb = k == 2 ? -1 : 15 - (u >> 5), bh = u & 31;
                att::attn_unit<0>(lds, AQ, 512, AK, AV, 512, CAT, 1536, k == 2 ? p : (bh & 7), k == 2 ? 0 : (bh >> 3), qb, BM, P.relb); }
    }
    SEAM(5);
    if (IN(6)) REPS(6) {
        PTRS();
        PHASE_IDS();
        pg8::Gemm g{CAT, WOUT0, 1536}; pg8::SchedPlain S; S.init(NMT - 1, 4, G, bx, 1);
        EpiResid<true> E{P, HB, SSQ};
        pg8::gemm_phase(lds, g, S, E);
        for (int j = vcu; j < 16; j += G) skinny_job<true, true>(lds, CAT, WOUT0, 1536, j, P, H, HB, SSQ, nullptr);
        for (int i = vcu * 512 + tid; i < MROW * DM * 2 / 16; i += G * 512) ((u32x4*)HB)[i] = (u32x4){0u, 0u, 0u, 0u};
    }
    SEAM(6);
    if (IN(7)) REPS(7) {
        PTRS();
        pg8::Gemm g{HB, WUG0, 1024}; pg8::SchedFfn S; S.init(G, bx);
        EpiFfn E{ACT, SSQ, P.convw, P.convb, (LAS float*)(lds + LDSX_OFF), (LAS float*)(lds + LDSX_OFF + 4096)};
        pg8::gemm_phase(lds, g, S, E);
    }
    SEAM(7);
    if (IN(8)) REPS(8) {
        PTRS();
        pg8::Gemm g{ACT, WDN0, DFF}; pg8::SchedPlain S; S.init(NMT - 1, 4, G, bx, 1);
        EpiResid<false> E{P, HB, SSQ};
        pg8::gemm_phase(lds, g, S, E);
        for (int j = vcu; j < 16; j += G) skinny_job<true, false>(lds, ACT, WDN0, DFF, j, P, H, HB, SSQ, nullptr);
    }
    SEAM(8);
    if (IN(9)) REPS(9) {
        PTRS();
        PHASE_IDS();
        pg8::Gemm g{HB, WIN1, 1024}; pg8::SchedPlain S; S.init(NMT - 1, 12, G, bx, 1);
        EpiQKV1 E{Q1, K1, V1, SSQ, (LAS float*)(lds + LDSX_OFF + 4096)};
        pg8::gemm_phase(lds, g, S, E);
        for (int j = vcu; j < 48; j += G) skinny_job<false, false>(lds, HB, WIN1, 1024, j, P, H, HB, SSQ, Q1);
        for (int i = vcu * 512 + tid; i < 3 * 48 * DM * 2 / 16; i += G * 512) { const int seg = i / (48 * 128), r = i % (48 * 128); ((u32x4*)(Q1 + (size_t)seg * ((WS_K1 - WS_Q1) / 2) + (size_t)192 * DM))[r] = (u32x4){0u, 0u, 0u, 0u}; }
    }
    SEAM(9);
    if (IN(10)) REPS(10) {
        PTRS();
        for (int u = vcu; u < 1040; u += G) { const int bh = u & 63; const int uh = u < 1024 ? (bh & 15) : u - 1024, ub = u < 1024 ? (bh >> 4) : 0, uq = u < 1024 ? 15 - (u >> 6) : -1;
            att::attn_unit<1>(lds, Q1, 1024, K1, V1, 1024, O1, 1024, uh, ub, uq, nullptr, nullptr); }
    }
    SEAM(10);
    if (IN(11)) REPS(11) {
        PTRS();
        pg8::Gemm g{O1, WOUT1, 1024}; pg8::SchedPlain S; S.init(NMT - 1, 4, G, bx, 1);
        EpiResid<false> E{P, HB, SSQ};
        pg8::gemm_phase(lds, g, S, E);
        for (int j = vcu; j < 16; j += G) skinny_job<true, false>(lds, O1, WOUT1, 1024, j, P, H, HB, SSQ, nullptr);
    }
    SEAM(11);
    if (IN(12)) REPS(12) {
        PTRS();
        pg8::Gemm g{HB, WUG1, 1024}; pg8::SchedFfn S; S.init(G, bx);
        EpiFfn E{ACT, SSQ, P.convw + 3 * DFF, P.convb + DFF, (LAS float*)(lds + LDSX_OFF), (LAS float*)(lds + LDSX_OFF + 4096)};
        pg8::gemm_phase(lds, g, S, E);
    }
    SEAM(12);
    if (IN(13)) REPS(13) {
        PTRS();
        pg8::Gemm g{ACT, WDN1, DFF}; pg8::SchedPlain S; S.init(NMT - 1, 4, G, bx, 1);
        EpiResid<false> E{P, HB, SSQ};
        pg8::gemm_phase(lds, g, S, E);
        for (int j = vcu; j < 16; j += G) skinny_job<true, false>(lds, ACT, WDN1, DFF, j, P, H, HB, SSQ, nullptr);
    }
    SEAM(13);
    if (IN(14)) REPS(14) {
        PTRS();
        PHASE_IDS();
        for (int r = ROW0 + gw; r < RT; r += NGW) { const float rn = row_rnorm(SSQ, r); const u32x4* hp = (const u32x4*)(HB + (size_t)r * DM); f32x4* op = (f32x4*)(P.out + (size_t)(r - ROW0) * DM);
#pragma unroll
            for (int j = 0; j < 2; ++j) { const u32x4 hb = hp[lane + 64 * j]; const f32x4 g0 = ((const f32x4*)P.nfin)[2 * (lane + 64 * j)], g1 = ((const f32x4*)P.nfin)[2 * (lane + 64 * j) + 1];
                const f32x4 v0 = {__uint_as_float(hb.x << 16), __uint_as_float(hb.x & 0xffff0000u), __uint_as_float(hb.y << 16), __uint_as_float(hb.y & 0xffff0000u)};
                const f32x4 v1 = {__uint_as_float(hb.z << 16), __uint_as_float(hb.z & 0xffff0000u), __uint_as_float(hb.w << 16), __uint_as_float(hb.w & 0xffff0000u)};
                op[2 * (lane + 64 * j)] = v0 * rn * g0; op[2 * (lane + 64 * j) + 1] = v1 * rn * g1; } }
    }
#undef IN
#undef SEAM
}

extern "C" void kernel_launch(void* const* d_in, const int* in_sizes, int n_in, void* d_out, int out_size, void* d_ws, size_t ws_size, hipStream_t stream) {
    static int grid = 0;
    if (grid == 0) {
        if (n_in != 16 || in_sizes[0] != NB * SEQ * DM || out_size != NB * SEQ * DM || ws_size < WS_END) { fprintf(stderr, "kernel_launch: unexpected shapes (n_in %d, in0 %d, out %d, ws %zu); nothing launched\n", n_in, n_in > 0 ? in_sizes[0] : -1, out_size, ws_size); grid = -1; return; }
        int dev = 0, cus = 0, per_cu = 0;
        if (hipGetDevice(&dev) != hipSuccess || hipDeviceGetAttribute(&cus, hipDeviceAttributeMultiprocessorCount, dev) != hipSuccess) { fprintf(stderr, "kernel_launch: device query failed\n"); grid = -1; return; }
        if (hipFuncSetAttribute((const void*)fwd_kernel, hipFuncAttributeMaxDynamicSharedMemorySize, LDS_BYTES) != hipSuccess) { fprintf(stderr, "kernel_launch: hipFuncSetAttribute failed\n"); grid = -1; return; }
        if (hipOccupancyMaxActiveBlocksPerMultiprocessor(&per_cu, (const void*)fwd_kernel, NWAVES * 64, LDS_BYTES) != hipSuccess || per_cu < 1) fprintf(stderr, "kernel_launch: note: occupancy query reports %d workgroups per CU\n", per_cu);
        (void)hipGetLastError();
        grid = cus;
    }
    if (grid < 0) return;
    if (hipMemsetAsync((char*)d_ws + WS_CTL, 0, CTL_ZERO_BYTES, stream) != hipSuccess) { fprintf(stderr, "kernel_launch: hipMemsetAsync failed\n"); return; }
    Params p{};
    p.x = (const float*)d_in[0]; p.meta = (const float*)d_in[1]; p.relb = (const float*)d_in[2]; p.nmix = (const float*)d_in[3]; p.nffn = (const float*)d_in[4]; p.nfin = (const float*)d_in[5];
    p.win0 = (const float*)d_in[6]; p.gng = (const float*)d_in[7]; p.wout0 = (const float*)d_in[8]; p.win1 = (const float*)d_in[9]; p.wout1 = (const float*)d_in[10];
    p.wup = (const float*)d_in[11]; p.wgate = (const float*)d_in[12]; p.convw = (const float*)d_in[13]; p.convb = (const float*)d_in[14]; p.wdown = (const float*)d_in[15];
    p.out = (float*)d_out; p.ws = (unsigned char*)d_ws; p.ph_lo = PH_LO; p.ph_hi = PH_HI;
    hipLaunchKernelGGL(fwd_kernel, dim3(grid), dim3(NWAVES * 64), LDS_BYTES, stream, p);
    const hipError_t le = hipPeekAtLastError();
    if (le != hipSuccess) fprintf(stderr, "kernel_launch: launch failed: %s\n", hipGetErrorName(le));
}
```
